# Optimizing an MI355X kernel written in HIP

```python
import math
import jax, jax.numpy as jnp
from jax import lax
import numpy as np

D_MODEL = 1024
BATCH = 16
SEQ = 2048
DEPTH = 1

GMLP_WIDTH = 512
GMLP_GROUPS = 4
GMLP_GROUP_DIM = GMLP_WIDTH // GMLP_GROUPS
CHUNK = 128

ATTN_PATTERNS = ((128, 1), (512, 4), (2048, 16))
N_ATTN_GROUPS = len(ATTN_PATTERNS)
HEADS_PER_GROUP = 4
HEAD_DIM = 128
ATTN_GROUP_WIDTH = HEADS_PER_GROUP * HEAD_DIM
ATTN_WIDTH = N_ATTN_GROUPS * ATTN_GROUP_WIDTH
ROPE_DIM = HEAD_DIM // 4
ROPE_THETA = 500000.0

N_BRANCHES = 2
D_FF = 4 * D_MODEL
D_IN = 2 * GMLP_WIDTH + 3 * ATTN_WIDTH + N_BRANCHES * D_MODEL
NORM_EPS = 1e-6
MASK_VALUE = -1e30

kernel_name = "hybrid_gmlp_dilated_attn_encoder_block"


def rms_norm(x, gain):
    xf = x.astype(jnp.float32)
    y = xf * lax.rsqrt(jnp.mean(xf * xf, axis=-1, keepdims=True) + NORM_EPS)
    return (y * gain.astype(jnp.float32)).astype(x.dtype)


def layer_norm(x, gain, bias):
    xf = x.astype(jnp.float32)
    mu = jnp.mean(xf, axis=-1, keepdims=True)
    var = jnp.mean(jnp.square(xf - mu), axis=-1, keepdims=True)
    y = (xf - mu) * lax.rsqrt(var + NORM_EPS)
    return (y * gain.astype(jnp.float32) + bias.astype(jnp.float32)).astype(x.dtype)


def partial_rope(t):
    S = t.shape[1]
    half = ROPE_DIM // 2
    inv_freq = ROPE_THETA ** (-jnp.arange(0, ROPE_DIM, 2, dtype=jnp.float32) / ROPE_DIM)
    ang = jnp.arange(S, dtype=jnp.float32)[:, None] * inv_freq[None, :]
    cos = jnp.cos(ang)[None, :, None, :]
    sin = jnp.sin(ang)[None, :, None, :]
    tf = t.astype(jnp.float32)
    x1, x2, rest = tf[..., :half], tf[..., half:ROPE_DIM], tf[..., ROPE_DIM:]
    out = jnp.concatenate([x1 * cos - x2 * sin, x2 * cos + x1 * sin, rest], axis=-1)
    return out.astype(t.dtype)


def dilated_window_attention(q, k, v, dilation, radius):
    B, S, H, Dh = q.shape
    L = S // dilation
    nb = -(-L // radius)
    Lp = nb * radius

    def strided(t):
        return t.astype(jnp.float32).reshape(B, L, dilation, H, Dh).transpose(0, 2, 1, 3, 4)

    qs, ks, vs = strided(q), strided(k), strided(v)
    qb = jnp.pad(qs, ((0, 0), (0, 0), (0, Lp - L), (0, 0), (0, 0))).reshape(B, dilation, nb, radius, H, Dh)

    def windows(t):
        tb = jnp.pad(t, ((0, 0), (0, 0), (radius, Lp - L + radius), (0, 0), (0, 0)))
        tb = tb.reshape(B, dilation, nb + 2, radius, H, Dh)
        return jnp.concatenate([tb[:, :, :-2], tb[:, :, 1:-1], tb[:, :, 2:]], axis=3)

    kw, vw = windows(ks), windows(vs)
    blk = jnp.arange(nb)[:, None, None]
    qpos = blk * radius + jnp.arange(radius)[None, :, None]
    kpos = blk * radius - radius + jnp.arange(3 * radius)[None, None, :]
    valid = (jnp.abs(qpos - kpos) <= radius) & (kpos >= 0) & (kpos < L)

    scale = 1.0 / math.sqrt(Dh)
    s = jnp.einsum('bdnqhe,bdnkhe->bdnhqk', qb, kw) * scale
    s = jnp.where(valid[None, None, :, None], s, MASK_VALUE)
    m = jnp.max(s, axis=-1, keepdims=True)
    p = jnp.exp(s - m)
    denom = jnp.sum(p, axis=-1, keepdims=True)
    o = jnp.einsum('bdnhqk,bdnkhe->bdnhqe', p, vw) / denom
    lse = (m + jnp.log(denom))[..., 0]

    o = o.transpose(0, 1, 2, 4, 3, 5).reshape(B, dilation, Lp, H, Dh)[:, :, :L]
    o = o.transpose(0, 2, 1, 3, 4).reshape(B, S, H, Dh)
    lse = lse.transpose(0, 1, 2, 4, 3).reshape(B, dilation, Lp, H)[:, :, :L]
    lse = lse.transpose(0, 2, 1, 3).reshape(B, S, H)
    return o, lse


def gmlp_spatial_gating(z, ln_gain, ln_bias, w_spatial, b_spatial):
    B, S, _ = z.shape
    u, v = z[..., :GMLP_WIDTH], z[..., GMLP_WIDTH:]
    v = layer_norm(v, ln_gain, ln_bias)
    v = v.reshape(B, S // CHUNK, CHUNK, GMLP_GROUPS, GMLP_GROUP_DIM)
    sv = jnp.einsum('bcsge,gts->bctge', v, w_spatial) + b_spatial.T[None, None, :, :, None]
    return u * sv.reshape(B, S, GMLP_WIDTH)


def setup_inputs(seed: int = 0) -> dict:
    key = jax.random.key(seed)
    ks = jax.random.split(key, 17)
    f32 = jnp.float32

    def nrm(k, shape, scale):
        return jax.random.normal(k, shape, f32) * scale

    def gain(k, shape):
        return 1.0 + 0.05 * jax.random.normal(k, shape, f32)

    return {
        "x": jax.random.normal(ks[0], (BATCH, SEQ, D_MODEL), f32),
        "norm_mix_pre": gain(ks[1], (DEPTH, D_MODEL)),
        "w_in": nrm(ks[2], (DEPTH, D_MODEL, D_IN), D_MODEL ** -0.5),
        "b_gate": nrm(ks[3], (DEPTH, N_BRANCHES * D_MODEL), 0.02),
        "ln_v_gain": gain(ks[4], (DEPTH, GMLP_WIDTH)),
        "ln_v_bias": nrm(ks[5], (DEPTH, GMLP_WIDTH), 0.02),
        "w_spatial": nrm(ks[6], (DEPTH, GMLP_GROUPS, CHUNK, CHUNK), CHUNK ** -0.5),
        "b_spatial": gain(ks[7], (DEPTH, GMLP_GROUPS, CHUNK)),
        "w_branch_a": nrm(ks[8], (DEPTH, GMLP_WIDTH, D_MODEL), GMLP_WIDTH ** -0.5),
        "w_branch_b": nrm(ks[9], (DEPTH, ATTN_GROUP_WIDTH, D_MODEL), ATTN_GROUP_WIDTH ** -0.5),
        "w_out": nrm(ks[10], (DEPTH, D_MODEL, D_MODEL), D_MODEL ** -0.5),
        "norm_mix_post": gain(ks[11], (DEPTH, D_MODEL)),
        "norm_mlp_pre": gain(ks[12], (DEPTH, D_MODEL)),
        "w_up": nrm(ks[13], (DEPTH, D_MODEL, D_FF), D_MODEL ** -0.5),
        "w_down": nrm(ks[14], (DEPTH, D_FF, D_MODEL), D_FF ** -0.5),
        "norm_mlp_post": gain(ks[15], (DEPTH, D_MODEL)),
    }


def reference(x, norm_mix_pre, w_in, b_gate, ln_v_gain, ln_v_bias, w_spatial, b_spatial,
              w_branch_a, w_branch_b, w_out, norm_mix_post, norm_mlp_pre, w_up, w_down,
              norm_mlp_post):
    B, S, D = x.shape
    split_points = list(np.cumsum([GMLP_WIDTH * 2, ATTN_WIDTH, ATTN_WIDTH, ATTN_WIDTH]))
    h = x
    for l in range(DEPTH):
        n = rms_norm(h, norm_mix_pre[l])
        proj = jnp.einsum('bsd,de->bse', n, w_in[l])
        z_gmlp, q, k, v, gates = jnp.split(proj, split_points, axis=-1)

        y_a = gmlp_spatial_gating(jax.nn.gelu(z_gmlp), ln_v_gain[l], ln_v_bias[l],
                                  w_spatial[l], b_spatial[l])

        n_heads = N_ATTN_GROUPS * HEADS_PER_GROUP
        q = partial_rope(q.reshape(B, S, n_heads, HEAD_DIM))
        k = partial_rope(k.reshape(B, S, n_heads, HEAD_DIM))
        v = v.reshape(B, S, n_heads, HEAD_DIM)
        outs, lses = [], []
        for g, (window, dilation) in enumerate(ATTN_PATTERNS):
            sl = slice(g * HEADS_PER_GROUP, (g + 1) * HEADS_PER_GROUP)
            o_g, lse_g = dilated_window_attention(q[:, :, sl], k[:, :, sl], v[:, :, sl],
                                                  dilation, window // (2 * dilation))
            outs.append(o_g)
            lses.append(lse_g)
        o_all = jnp.stack(outs, axis=0)
        w_mix = jax.nn.softmax(jnp.stack(lses, axis=0), axis=0)
        y_b = jnp.sum(w_mix[..., None] * o_all, axis=0).reshape(B, S, ATTN_GROUP_WIDTH).astype(h.dtype)

        g_all = jax.nn.sigmoid((gates + b_gate[l]).astype(jnp.float32)).astype(h.dtype)
        g_a, g_b = g_all[..., :D_MODEL], g_all[..., D_MODEL:]
        merged = (g_a * jnp.einsum('bse,ed->bsd', y_a, w_branch_a[l])
                  + g_b * jnp.einsum('bse,ed->bsd', y_b, w_branch_b[l]))
        mix_out = jnp.einsum('bsd,de->bse', merged, w_out[l])
        h = h + rms_norm(mix_out, norm_mix_post[l])

        n2 = rms_norm(h, norm_mlp_pre[l])
        hid = jnp.square(jax.nn.relu(jnp.einsum('bsd,df->bsf', n2, w_up[l])))
        mlp_out = jnp.einsum('bsf,fd->bsd', hid, w_down[l])
        h = h + rms_norm(mlp_out, norm_mlp_post[l])
    return h
```

```cpp
#include <hip/hip_runtime.h>
#include <hip/hip_cooperative_groups.h>
#include <cstdio>
#include <cstdint>
namespace cg = cooperative_groups;

#define LAS __attribute__((address_space(3)))
typedef unsigned short bf16_t;
typedef short bf16x8 __attribute__((ext_vector_type(8)));
typedef float f32x4 __attribute__((ext_vector_type(4)));
typedef float f32x16 __attribute__((ext_vector_type(16)));
typedef unsigned u32x4 __attribute__((ext_vector_type(4)));
typedef unsigned u32x2 __attribute__((ext_vector_type(2)));
typedef float f32x2 __attribute__((ext_vector_type(2)));

constexpr int NB = 16, SEQ = 2048, M = NB * SEQ, D = 1024, DIN = 7680, FF = 4096;
constexpr float EPS = 1e-6f;
constexpr size_t MiB = (size_t)1 << 20;
constexpr size_t WS_Z = 0;
constexpr size_t WS_Q = 64 * MiB;
constexpr size_t WS_K = 160 * MiB;
constexpr size_t WS_VT = 256 * MiB;
constexpr size_t WS_G = 352 * MiB;
constexpr size_t WS_WAB = 480 * MiB;
constexpr size_t WS_WOUT = 482 * MiB;
constexpr size_t WS_WUP = 484 * MiB;
constexpr size_t WS_WDOWN = 492 * MiB;
constexpr size_t WS_WSP = 500 * MiB;
constexpr size_t WS_ROPE = 501 * MiB;
constexpr size_t WS_RSTD0 = 502 * MiB;
constexpr size_t WS_SS1 = WS_RSTD0 + 131072;
constexpr size_t WS_SS2 = WS_SS1 + 131072;
constexpr size_t WS_E2 = WS_SS2 + 131072;
constexpr size_t WS_RSTDU = WS_E2 + 131072;
constexpr size_t WS_BAR = 503 * MiB;
constexpr size_t WS_NEED = 504 * MiB;
constexpr size_t WS_MERGED = 64 * MiB;
constexpr size_t WS_MIX = 128 * MiB;
constexpr size_t WS_H1B = 0;
constexpr size_t WS_HID = 192 * MiB;
constexpr size_t WS_MLP = 64 * MiB;
constexpr size_t DO_XB = 0;
constexpr size_t DO_WIN = 64 * MiB;
constexpr size_t DO_OG = 0;
constexpr size_t DO_LSE = 96 * MiB;

constexpr int LDS_BYTES = 147456;
constexpr int VT_PITCH = 272;

__device__ __forceinline__ unsigned cvt_pk_bf16(float lo, float hi) { unsigned r; asm volatile("v_cvt_pk_bf16_f32 %0, %1, %2" : "=v"(r) : "v"(lo), "v"(hi)); return r; }
__device__ __forceinline__ float bf_lo(unsigned w) { return __uint_as_float(w << 16); }
__device__ __forceinline__ float bf_hi(unsigned w) { return __uint_as_float(w & 0xffff0000u); }
__device__ __forceinline__ float wave_sum(float v) {
#pragma unroll
    for (int o = 1; o < 64; o <<= 1) v += __shfl_xor(v, o);
    return v;
}

__device__ __forceinline__ int tid_fresh();
namespace pg8 {
constexpr int BM = 256, BK = 64, HALF = 128, HTB = HALF * BK * 2, STAGE_BYTES = 8 * HTB, NXCD = 8, WGM = 8;
__host__ __device__ __forceinline__ int lds_byte(int r, int c) { const int st = (r >> 4) * 2 + (c >> 5), rr = r & 15, cc = c & 31, ob = rr * 64 + cc * 2; return st * 1024 + (ob ^ (((ob >> 9) & 1) << 5)); }
__host__ __device__ __forceinline__ void stage_rc(int b, int& R, int& C) { const int st = b / 1024, sb = b % 1024, swz = sb ^ (((sb >> 9) & 1) << 5); R = (st >> 1) * 16 + swz / 64; C = (st & 1) * 32 + (swz % 64) / 2; }
__host__ __device__ __forceinline__ int perm32(int rho) { const int n = rho >> 4, i = rho & 15; return 8 * (i >> 2) + 4 * n + (i & 3); }

struct Unit { int pm, pn; unsigned aoff, boff; int part; };
struct Gemm { const bf16_t* A; const bf16_t* Bt; int lda, ldb, K; int bmode, bd; };
__device__ __forceinline__ int rowmapB(int R, int bmode, int bd) { return bmode == 0 ? R : (bmode == 1 ? R * bd : ((R & 127) * 16 + (R >> 7))); }

__device__ __forceinline__ void tile_of(int L, int nM, int nN, int& pm, int& pn) {
    const int nwg = nM * nN; int wgid = L;
    { const int q = nwg / NXCD, r = nwg % NXCD, xcd = wgid % NXCD, off = wgid / NXCD; wgid = (xcd < r ? xcd * (q + 1) : r * (q + 1) + (xcd - r) * q) + off; }
    const int nig = WGM * nN, gid = wgid / nig, fm = gid * WGM, gsz = (nM - fm) < WGM ? (nM - fm) : WGM;
    pm = fm + ((wgid % nig) % gsz); pn = (wgid % nig) / gsz;
}
struct StaticOrder {
    int nM, nN, nwg, G, c;
    __device__ __forceinline__ void init(int M_, int N_, int G_, int c_) { nM = M_ / BM; nN = N_ / BM; nwg = nM * nN; G = G_; c = c_; }
    __device__ __forceinline__ bool next(int i, Unit& u) const {
        const long L = (long)i * G + c; if (L >= nwg) return false;
        tile_of((int)L, nM, nN, u.pm, u.pn); u.aoff = 0; u.boff = 0; u.part = 0; return true;
    }
};
struct InOrder {
    int nM, nN, nwg, G, c;
    __device__ __forceinline__ void init(int M_, int G_, int c_) { nM = M_ / BM; nN = 24; nwg = nM * nN; G = G_; c = c_; }
    __device__ __forceinline__ bool next(int i, Unit& u) const {
        const long L = (long)i * G + c; if (L >= nwg) return false;
        tile_of((int)L, nM, nN, u.pm, u.pn); if (u.pn >= 16) u.pn += 6; u.aoff = 0; u.boff = 0; u.part = 0; return true;
    }
};
struct VtOrder {
    int g, G, c;
    __device__ __forceinline__ void init(int g_, int G_, int c_) { g = g_; G = G_; c = c_; }
    __device__ __forceinline__ bool next(int i, Unit& u) const {
        const int L = i * G + c; if (L >= 256) return false;
        u.pm = 2 * g + (L & 1); u.pn = L >> 1;
        const int b = u.pn >> 3, t8 = u.pn & 7; int row0;
        if (g == 2) row0 = b * 2048 + 2 * t8;
        else { const int shift = 2 * g, lb = 11 - shift, u0 = t8 * 256; row0 = b * 2048 + ((u0 & ((1 << lb) - 1)) << shift) + (u0 >> lb); }
        u.aoff = 0; u.boff = (unsigned)row0 * 2048u; u.part = 0; return true;
    }
};
struct TwoPartOrder {
    int nM, nN, nwg, G, c;
    __device__ __forceinline__ void init(int M_, int N_, int G_, int c_) { nM = M_ / BM; nN = N_ / BM; nwg = nM * nN; G = G_; c = c_; }
    __device__ __forceinline__ bool next(int i, Unit& u) const {
        const long L = (long)(i >> 1) * G + c; if (L >= nwg) return false;
        tile_of((int)L, nM, nN, u.pm, u.pn);
        if (i & 1) { u.aoff = 512u * 2u; u.boff = 1024u * 512u * 2u; u.part = 2; } else { u.aoff = 0; u.boff = 0; u.part = 1; }
        return true;
    }
};

template <class Epi, class Sched, bool ALIGN_EPI, bool SP2>
__device__ __forceinline__ void gemm_phase(LAS unsigned char* lds, const Gemm g, const Sched& S, const Epi& E) {
    const int tid = tid_fresh(), wid = __builtin_amdgcn_readfirstlane(tid >> 6), lane = tid & 63, wr = wid >> 2, wc = wid & 3, fr = lane & 15, fq = lane >> 4;
    const int K = g.K, nt = K / BK;
    unsigned voffA[2], voffB[2];
#pragma unroll
    for (int i = 0; i < 2; ++i) { int R, C; stage_rc(tid * 16 + i * 8192, R, C); const int Rb = Epi::PERM ? ((R & ~31) + perm32(R & 31)) : R;
        voffA[i] = (unsigned)(R * g.lda + C) * 2u; voffB[i] = (unsigned)(rowmapB(Rb, g.bmode, g.bd) * g.ldb + C) * 2u; }
    const size_t kstep = (size_t)(BK * 2);
    const size_t hstepA = (size_t)HALF * g.lda * 2, hstepB = (size_t)rowmapB(HALF, g.bmode, g.bd) * g.ldb * 2;
    const size_t tstepA = 2 * hstepA, tstepB = g.bmode ? (size_t)0 : 2 * hstepB;
    const unsigned ldsw = (unsigned)wid * 1024u;
    const int aoff = lds_byte(wr * 64 + fr, fq * 8), boff = lds_byte(wc * 32 + fr, fq * 8);
#define PG8_SA(b, h) (((b) * 2 + (h)) * HTB)
#define PG8_SB(b, h) ((4 + (b) * 2 + (h)) * HTB)
#define PG8_STAGE(bufoff, gbase, voff) do { _Pragma("unroll") for (int _i = 0; _i < 2; ++_i) \
        __builtin_amdgcn_global_load_lds((const unsigned*)((const char*)(gbase) + (voff)[_i]), (LAS unsigned*)(lds + (bufoff) + ldsw + _i * 8192), 16, 0, 0); } while (0)
#define PG8_LDA(dst, b, h) do { _Pragma("unroll") for (int m = 0; m < 4; ++m) _Pragma("unroll") for (int k = 0; k < 2; ++k) dst[m][k] = *(const LAS bf16x8*)(lds + PG8_SA(b, h) + aoff + m * 2048 + k * 1024); } while (0)
#define PG8_LDB(dst, b, h) do { _Pragma("unroll") for (int n = 0; n < 2; ++n) _Pragma("unroll") for (int k = 0; k < 2; ++k) dst[n][k] = *(const LAS bf16x8*)(lds + PG8_SB(b, h) + boff + n * 2048 + k * 1024); } while (0)
#define PG8_MMA(ai, bj, At, Bt) do { __builtin_amdgcn_s_setprio(1); _Pragma("unroll") for (int m = 0; m < 4; ++m) _Pragma("unroll") for (int n = 0; n < 2; ++n) _Pragma("unroll") for (int k = 0; k < 2; ++k) \
        acc[ai][bj][m][n] = __builtin_amdgcn_mfma_f32_16x16x32_bf16(Bt[n][k], At[m][k], acc[ai][bj][m][n], 0, 0, 0); __builtin_amdgcn_s_setprio(0); } while (0)
#define PG8_WAIT_V(n) asm volatile("s_waitcnt vmcnt(" #n ")" ::: "memory")
#define PG8_WAIT_L(n) asm volatile("s_waitcnt lgkmcnt(" #n ")" ::: "memory")
#define PG8_BAR __builtin_amdgcn_s_barrier()
#define PG8_SCHED __builtin_amdgcn_sched_barrier(0)
    Unit cur, nxt; int ui = 0;
    if (!S.next(0, cur)) return;
    f32x4 acc[2][2][4][2];
#pragma unroll
    for (int a = 0; a < 2; ++a)
#pragma unroll
        for (int b = 0; b < 2; ++b)
#pragma unroll
            for (int m = 0; m < 4; ++m)
#pragma unroll
                for (int n = 0; n < 2; ++n) acc[a][b][m][n] = (f32x4){0.f, 0.f, 0.f, 0.f};
    bf16x8 At[4][2], B0[2][2], B1[2][2];
    const char* cA = (const char*)g.A + (size_t)cur.pm * tstepA + cur.aoff; const char* cB = (const char*)g.Bt + (size_t)cur.pn * tstepB + cur.boff;
    if constexpr (SP2) {
        PG8_STAGE(PG8_SB(0, 0), cB, voffB); PG8_STAGE(PG8_SB(0, 1), cB + hstepB, voffB); PG8_STAGE(PG8_SA(0, 0), cA, voffA); PG8_STAGE(PG8_SA(0, 1), cA + hstepA, voffA);
        if (wr == 1) PG8_BAR;
        PG8_WAIT_V(2); PG8_BAR;
        PG8_STAGE(PG8_SB(1, 0), cB + kstep, voffB); PG8_STAGE(PG8_SA(1, 0), cA + kstep, voffA); PG8_STAGE(PG8_SB(1, 1), cB + hstepB + kstep, voffB);
        PG8_WAIT_V(6); PG8_BAR;
    } else {
        PG8_STAGE(PG8_SB(0, 0), cB, voffB); PG8_STAGE(PG8_SA(0, 0), cA, voffA); PG8_STAGE(PG8_SB(0, 1), cB + hstepB, voffB); PG8_STAGE(PG8_SA(0, 1), cA + hstepA, voffA);
        if (wr == 1) PG8_BAR;
        PG8_WAIT_V(4); PG8_BAR;
        PG8_STAGE(PG8_SB(1, 0), cB + kstep, voffB); PG8_STAGE(PG8_SA(1, 0), cA + kstep, voffA); PG8_STAGE(PG8_SB(1, 1), cB + hstepB + kstep, voffB);
        PG8_WAIT_V(6); PG8_BAR;
    }
    for (;;) {
        const bool has_next = S.next(ui + 1, nxt);
        const char* nA = has_next ? (const char*)g.A + (size_t)nxt.pm * tstepA + nxt.aoff : cA; const char* nB = has_next ? (const char*)g.Bt + (size_t)nxt.pn * tstepB + nxt.boff : cB;
        for (int t = 0; t < nt; t += 2) {
            const bool last = (t == nt - 2);
            const char* a1 = cA + (size_t)(t + 1) * kstep;
            const char* a2 = last ? nA : cA + (size_t)(t + 2) * kstep; const char* b2 = last ? nB : cB + (size_t)(t + 2) * kstep;
            const char* a3 = a2 + kstep; const char* b3 = b2 + kstep;
            if constexpr (SP2) {
            PG8_LDB(B0, 0, 0); PG8_LDB(B1, 0, 1); PG8_SCHED; PG8_LDA(At, 0, 0); PG8_STAGE(PG8_SA(1, 1), a1 + hstepA, voffA);
            PG8_WAIT_V(8); PG8_WAIT_L(0); PG8_BAR; PG8_MMA(0, 0, At, B0); PG8_MMA(0, 1, At, B1); PG8_BAR; PG8_SCHED;
            PG8_LDA(At, 0, 1); PG8_STAGE(PG8_SB(0, 0), b2, voffB); PG8_STAGE(PG8_SB(0, 1), b2 + hstepB, voffB); PG8_STAGE(PG8_SA(0, 0), a2, voffA);
            PG8_WAIT_V(8); PG8_WAIT_L(0); PG8_BAR; PG8_MMA(1, 0, At, B0); PG8_MMA(1, 1, At, B1); PG8_BAR; PG8_SCHED;
            PG8_LDB(B0, 1, 0); PG8_LDB(B1, 1, 1); PG8_SCHED; PG8_LDA(At, 1, 0); PG8_STAGE(PG8_SA(0, 1), a2 + hstepA, voffA);
            PG8_WAIT_V(8); PG8_WAIT_L(0); PG8_BAR; PG8_MMA(0, 0, At, B0); PG8_MMA(0, 1, At, B1); PG8_BAR; PG8_SCHED;
            PG8_LDA(At, 1, 1); PG8_STAGE(PG8_SB(1, 0), b3, voffB); PG8_STAGE(PG8_SB(1, 1), b3 + hstepB, voffB); PG8_STAGE(PG8_SA(1, 0), a3, voffA);
            PG8_WAIT_V(8); PG8_WAIT_L(0); PG8_BAR; PG8_MMA(1, 0, At, B0); PG8_MMA(1, 1, At, B1); PG8_BAR; PG8_SCHED;
            } else {
            PG8_LDB(B0, 0, 0); PG8_SCHED; PG8_LDA(At, 0, 0); PG8_STAGE(PG8_SA(1, 1), a1 + hstepA, voffA);
            PG8_WAIT_L(8); PG8_BAR; PG8_WAIT_L(0); PG8_MMA(0, 0, At, B0); PG8_BAR; PG8_SCHED;
            PG8_LDB(B1, 0, 1); PG8_STAGE(PG8_SB(0, 0), b2, voffB);
            PG8_BAR; PG8_WAIT_L(0); PG8_MMA(0, 1, At, B1); PG8_BAR;
            PG8_LDA(At, 0, 1); PG8_STAGE(PG8_SA(0, 0), a2, voffA);
            PG8_BAR; PG8_WAIT_L(0); PG8_MMA(1, 0, At, B0); PG8_BAR; PG8_SCHED;
            PG8_STAGE(PG8_SB(0, 1), b2 + hstepB, voffB);
            PG8_WAIT_V(6); PG8_BAR; PG8_MMA(1, 1, At, B1); PG8_BAR;
            PG8_LDB(B0, 1, 0); PG8_SCHED; PG8_LDA(At, 1, 0); PG8_STAGE(PG8_SA(0, 1), a2 + hstepA, voffA);
            PG8_WAIT_L(8); PG8_BAR; PG8_WAIT_L(0); PG8_MMA(0, 0, At, B0); PG8_BAR; PG8_SCHED;
            PG8_LDB(B1, 1, 1); PG8_STAGE(PG8_SB(1, 0), b3, voffB);
            PG8_BAR; PG8_WAIT_L(0); PG8_MMA(0, 1, At, B1); PG8_BAR;
            PG8_LDA(At, 1, 1); PG8_STAGE(PG8_SA(1, 0), a3, voffA);
            PG8_BAR; PG8_WAIT_L(0); PG8_MMA(1, 0, At, B0); PG8_BAR; PG8_SCHED;
            PG8_STAGE(PG8_SB(1, 1), b3 + hstepB, voffB);
            PG8_WAIT_V(6); PG8_BAR; PG8_MMA(1, 1, At, B1); PG8_BAR;
            }
        }
        if constexpr (ALIGN_EPI) { if (wr == 0) PG8_BAR; }
        E(acc, cur, wr, wc, fr, fq);
        if (!has_next) break;
        if (cur.part != 1) {
#pragma unroll
        for (int a = 0; a < 2; ++a)
#pragma unroll
            for (int b = 0; b < 2; ++b)
#pragma unroll
                for (int m = 0; m < 4; ++m)
#pragma unroll
                    for (int n = 0; n < 2; ++n) acc[a][b][m][n] = (f32x4){0.f, 0.f, 0.f, 0.f};
        }
        cur = nxt; cA = nA; cB = nB; ++ui;
        if constexpr (ALIGN_EPI) { if (wr == 1) PG8_BAR; }
    }
    PG8_WAIT_V(0);
    if constexpr (!ALIGN_EPI) { if (wr == 0) PG8_BAR; }
    PG8_BAR;
#undef PG8_SA
#undef PG8_SB
#undef PG8_STAGE
#undef PG8_LDA
#undef PG8_LDB
#undef PG8_MMA
#undef PG8_WAIT_V
#undef PG8_WAIT_L
#undef PG8_BAR
#undef PG8_SCHED
}

__device__ __forceinline__ float gelu_tanh(float x) {
    const float t = 1.5957691216f * (x + 0.044715f * x * x * x);
    return x * __builtin_amdgcn_rcpf(1.0f + __expf(-t));
}
__device__ __forceinline__ float sigmoid_c(float x) { const float s = __builtin_amdgcn_rcpf(1.0f + __expf(-x)); return s < 1e-30f ? 1e-30f : s; }

struct EpiIn {
    static constexpr bool PERM = true;
    const float* rstd0; bf16_t* Z; bf16_t* Q; bf16_t* Kb; bf16_t* G; const float* bgate; const float2* rope;
    __device__ __forceinline__ void operator()(f32x4 (&acc)[2][2][4][2], const Unit& u, int wr, int wc, int fr, int fq) const {
        const int cb = u.pn * BM;
        const int row0 = u.pm * BM + wr * 64 + fr;
        const int cl = wc * 32 + fq * 8;
        float rsv[8];
#pragma unroll
        for (int i = 0; i < 8; ++i) rsv[i] = rstd0[row0 + (i >> 2) * HALF + (i & 3) * 16];
        if (cb < 1024) {
#pragma unroll
            for (int i = 0; i < 8; ++i) { const int ai = i >> 2, m = i & 3; const int row = row0 + ai * HALF + m * 16; const float rs = rsv[i]; bf16_t* rp = Z + (size_t)row * 1024 + cb + cl;
#pragma unroll
                for (int bj = 0; bj < 2; ++bj) { const f32x4 v0 = acc[ai][bj][m][0] * rs, v1 = acc[ai][bj][m][1] * rs; u32x4 w;
                    w.x = cvt_pk_bf16(gelu_tanh(v0[0]), gelu_tanh(v0[1])); w.y = cvt_pk_bf16(gelu_tanh(v0[2]), gelu_tanh(v0[3]));
                    w.z = cvt_pk_bf16(gelu_tanh(v1[0]), gelu_tanh(v1[1])); w.w = cvt_pk_bf16(gelu_tanh(v1[2]), gelu_tanh(v1[3]));
                    *(u32x4*)(rp + bj * HALF) = w; }
                asm volatile("" ::: "memory"); }
        } else if (cb < 4096) {
            const bool isq = cb < 2560; bf16_t* base = isq ? Q : Kb; const int c0 = cb - (isq ? 1024 : 2560);
            const float sc = isq ? 0.12751741f : 1.0f;
            const int hd0 = c0 >> 7, shift = 2 * (hd0 >> 2);
            const float sgn = (fq < 2) ? -1.0f : 1.0f;
            f32x4 cs[4], csn[4];
            if (wc == 0) { const f32x4* rpp = (const f32x4*)(rope + (size_t)(row0 & (SEQ - 1)) * 16 + (fq & 1) * 8); cs[0] = rpp[0]; cs[1] = rpp[1]; cs[2] = rpp[2]; cs[3] = rpp[3]; }
#pragma unroll
            for (int i = 0; i < 8; ++i) { const int ai = i >> 2, m = i & 3; const int row = row0 + ai * HALF + m * 16; const float rs = rsv[i] * sc;
                if (wc == 0 && i < 7) { const int rown = row0 + ((i + 1) >> 2) * HALF + ((i + 1) & 3) * 16;
                    const f32x4* rpp = (const f32x4*)(rope + (size_t)(rown & (SEQ - 1)) * 16 + (fq & 1) * 8); csn[0] = rpp[0]; csn[1] = rpp[1]; csn[2] = rpp[2]; csn[3] = rpp[3]; }
                const int bb = row >> 11, sq = row & (SEQ - 1), uu = ((sq & ((1 << shift) - 1)) << (11 - shift)) + (sq >> shift);
                bf16_t* rp = base + ((size_t)(bb * 12 + hd0) * SEQ + uu) * 128 + cl;
#pragma unroll
                for (int bj = 0; bj < 2; ++bj) { f32x4 v0 = acc[ai][bj][m][0] * rs, v1 = acc[ai][bj][m][1] * rs;
                    if (wc == 0) { f32x4 p0, p1;
#pragma unroll
                        for (int j = 0; j < 4; ++j) { p0[j] = __shfl_xor(v0[j], 32); p1[j] = __shfl_xor(v1[j], 32); }
                        v0[0] = v0[0] * cs[0][0] + sgn * p0[0] * cs[0][1]; v0[1] = v0[1] * cs[0][2] + sgn * p0[1] * cs[0][3];
                        v0[2] = v0[2] * cs[1][0] + sgn * p0[2] * cs[1][1]; v0[3] = v0[3] * cs[1][2] + sgn * p0[3] * cs[1][3];
                        v1[0] = v1[0] * cs[2][0] + sgn * p1[0] * cs[2][1]; v1[1] = v1[1] * cs[2][2] + sgn * p1[1] * cs[2][3];
                        v1[2] = v1[2] * cs[3][0] + sgn * p1[2] * cs[3][1]; v1[3] = v1[3] * cs[3][2] + sgn * p1[3] * cs[3][3]; }
                    u32x4 w; w.x = cvt_pk_bf16(v0[0], v0[1]); w.y = cvt_pk_bf16(v0[2], v0[3]); w.z = cvt_pk_bf16(v1[0], v1[1]); w.w = cvt_pk_bf16(v1[2], v1[3]);
                    *(u32x4*)(rp + (size_t)bj * SEQ * 128) = w; }
                if (wc == 0 && i < 7) { cs[0] = csn[0]; cs[1] = csn[1]; cs[2] = csn[2]; cs[3] = csn[3]; }
                asm volatile("" ::: "memory"); }
        } else {
            const int c0 = cb - 5632;
            f32x4 bg[2][2];
#pragma unroll
            for (int bj = 0; bj < 2; ++bj) { bg[bj][0] = *(const f32x4*)(bgate + c0 + cl + bj * HALF); bg[bj][1] = *(const f32x4*)(bgate + c0 + cl + bj * HALF + 4); }
#pragma unroll
            for (int i = 0; i < 8; ++i) { const int ai = i >> 2, m = i & 3; const int row = row0 + ai * HALF + m * 16; const float rs = rsv[i]; bf16_t* rp = G + (size_t)row * 2048 + c0 + cl;
#pragma unroll
                for (int bj = 0; bj < 2; ++bj) { const f32x4 v0 = acc[ai][bj][m][0] * rs + bg[bj][0], v1 = acc[ai][bj][m][1] * rs + bg[bj][1]; u32x4 w;
                    w.x = cvt_pk_bf16(sigmoid_c(v0[0]), sigmoid_c(v0[1])); w.y = cvt_pk_bf16(sigmoid_c(v0[2]), sigmoid_c(v0[3]));
                    w.z = cvt_pk_bf16(sigmoid_c(v1[0]), sigmoid_c(v1[1])); w.w = cvt_pk_bf16(sigmoid_c(v1[2]), sigmoid_c(v1[3]));
                    *(u32x4*)(rp + bj * HALF) = w; }
                asm volatile("" ::: "memory"); }
        }
    }
};
struct EpiVT {
    static constexpr bool PERM = true;
    const float* rstdu; bf16_t* VT; int g;
    __device__ __forceinline__ void operator()(f32x4 (&acc)[2][2][4][2], const Unit& u, int wr, int wc, int fr, int fq) const {
        const int b = u.pn >> 3, t8 = u.pn & 7;
        const int r0 = (u.pm & 1) * BM + wr * 64 + fr;
        f32x4 rs[2][2];
#pragma unroll
        for (int bj = 0; bj < 2; ++bj) { const float* rp = rstdu + (size_t)g * M + (size_t)u.pn * BM + bj * HALF + wc * 32 + fq * 8; rs[bj][0] = *(const f32x4*)rp; rs[bj][1] = *(const f32x4*)(rp + 4); }
#pragma unroll
        for (int ai = 0; ai < 2; ++ai)
#pragma unroll
            for (int m = 0; m < 4; ++m) { const int r = r0 + ai * HALF + m * 16; const int hd = 4 * g + (r >> 7), dimh = r & 127;
#pragma unroll
                for (int bj = 0; bj < 2; ++bj) { const int kt = t8 * 8 + bj * 4 + wc;
                    const f32x4 v0 = acc[ai][bj][m][0] * rs[bj][0], v1 = acc[ai][bj][m][1] * rs[bj][1];
                    u32x4 w; w.x = cvt_pk_bf16(v0[0], v0[1]); w.y = cvt_pk_bf16(v0[2], v0[3]); w.z = cvt_pk_bf16(v1[0], v1[1]); w.w = cvt_pk_bf16(v1[2], v1[3]);
                    *(u32x4*)(VT + ((size_t)((b * 12 + hd) * 64 + kt) * 128 + dimh) * 32 + fq * 8) = w; } }
    }
};

struct EpiMerge {
    static constexpr bool PERM = true;
    const bf16_t* G; bf16_t* O;
    __device__ __forceinline__ void operator()(f32x4 (&acc)[2][2][4][2], const Unit& u, int wr, int wc, int fr, int fq) const {
        const int row0 = u.pm * BM + wr * 64 + fr, col0 = u.pn * BM + wc * 32 + 8 * fq;
        const bool first = (u.part == 1);
        u32x4 ga[2], gb[2], gan[2], gbn[2];
        { const bf16_t* gp = G + (size_t)row0 * 2048 + col0;
#pragma unroll
          for (int bj = 0; bj < 2; ++bj) { gb[bj] = *(const u32x4*)(gp + 1024 + bj * HALF); if (first) ga[bj] = *(const u32x4*)(gp + bj * HALF); } }
#pragma unroll
        for (int i = 0; i < 8; ++i) { const int ai = i >> 2, m = i & 3; const int row = row0 + ai * HALF + m * 16;
            if (i < 7) { const bf16_t* gp = G + (size_t)(row0 + ((i + 1) >> 2) * HALF + ((i + 1) & 3) * 16) * 2048 + col0;
#pragma unroll
                for (int bj = 0; bj < 2; ++bj) { gbn[bj] = *(const u32x4*)(gp + 1024 + bj * HALF); if (first) gan[bj] = *(const u32x4*)(gp + bj * HALF); } }
#pragma unroll
            for (int bj = 0; bj < 2; ++bj) {
                f32x4 b0 = {bf_lo(gb[bj].x), bf_hi(gb[bj].x), bf_lo(gb[bj].y), bf_hi(gb[bj].y)}, b1 = {bf_lo(gb[bj].z), bf_hi(gb[bj].z), bf_lo(gb[bj].w), bf_hi(gb[bj].w)};
                if (first) {
                    f32x4 a0 = {bf_lo(ga[bj].x), bf_hi(ga[bj].x), bf_lo(ga[bj].y), bf_hi(ga[bj].y)}, a1 = {bf_lo(ga[bj].z), bf_hi(ga[bj].z), bf_lo(ga[bj].w), bf_hi(ga[bj].w)};
                    f32x4 r0, r1;
#pragma unroll
                    for (int j = 0; j < 4; ++j) { r0[j] = a0[j] * __builtin_amdgcn_rcpf(b0[j]); r1[j] = a1[j] * __builtin_amdgcn_rcpf(b1[j]); }
                    acc[ai][bj][m][0] = acc[ai][bj][m][0] * r0; acc[ai][bj][m][1] = acc[ai][bj][m][1] * r1;
                } else { const f32x4 v0 = acc[ai][bj][m][0] * b0, v1 = acc[ai][bj][m][1] * b1;
                    u32x4 w; w.x = cvt_pk_bf16(v0[0], v0[1]); w.y = cvt_pk_bf16(v0[2], v0[3]); w.z = cvt_pk_bf16(v1[0], v1[1]); w.w = cvt_pk_bf16(v1[2], v1[3]);
                    *(u32x4*)(O + (size_t)row * 1024 + col0 + bj * HALF) = w; } }
            if (i < 7) { gb[0] = gbn[0]; gb[1] = gbn[1]; if (first) { ga[0] = gan[0]; ga[1] = gan[1]; } }
            asm volatile("" ::: "memory"); }
    }
};

template <int ACT, bool SS> struct EpiStore {
    static constexpr bool PERM = true;
    bf16_t* O; int ldc; float* ss;
    __device__ __forceinline__ void operator()(f32x4 (&acc)[2][2][4][2], const Unit& u, int wr, int wc, int fr, int fq) const {
        const int row0 = u.pm * BM + wr * 64 + fr, col0 = u.pn * BM + wc * 32 + 8 * fq;
#pragma unroll
        for (int ai = 0; ai < 2; ++ai)
#pragma unroll
            for (int m = 0; m < 4; ++m) { const int row = row0 + ai * HALF + m * 16; bf16_t* rp = O + (size_t)row * ldc + col0; float s = 0.f;
#pragma unroll
                for (int bj = 0; bj < 2; ++bj) { f32x4 v0 = acc[ai][bj][m][0], v1 = acc[ai][bj][m][1];
                    if (ACT == 1) {
#pragma unroll
                        for (int j = 0; j < 4; ++j) { const float a = fmaxf(v0[j], 0.f), b = fmaxf(v1[j], 0.f); v0[j] = a * a; v1[j] = b * b; } }
                    if (SS) s += (v0[0] * v0[0] + v0[1] * v0[1]) + (v0[2] * v0[2] + v0[3] * v0[3]) + (v1[0] * v1[0] + v1[1] * v1[1]) + (v1[2] * v1[2] + v1[3] * v1[3]);
                    u32x4 w; w.x = cvt_pk_bf16(v0[0], v0[1]); w.y = cvt_pk_bf16(v0[2], v0[3]); w.z = cvt_pk_bf16(v1[0], v1[1]); w.w = cvt_pk_bf16(v1[2], v1[3]);
                    *(u32x4*)(rp + bj * HALF) = w; }
                if (SS) { s += __shfl_xor(s, 16); s += __shfl_xor(s, 32); if (fq == 0) atomicAdd(ss + row, s); } }
    }
};
}

struct Params { const float* in[16]; float* out; unsigned char* ws; };
typedef const Params __attribute__((address_space(4))) CParams;
__device__ __forceinline__ Params load_params() {
    CParams* pp = (CParams*)__builtin_amdgcn_kernarg_segment_ptr();
    asm volatile("" : "+s"(pp));
    Params q;
#pragma unroll
    for (int i = 0; i < 16; ++i) q.in[i] = pp->in[i];
    q.out = pp->out; q.ws = pp->ws; return q;
}

__device__ __forceinline__ void p0_transpose_item(const float* W, int K, int N, bf16_t* WT, int ldk, const float* gain, LAS float* scr, int item, int lane) {
    const int nblk = N / 32, kb = item / nblk, nb = item % nblk, k0 = 64 * kb, n0 = 32 * nb;
    float wv[32];
#pragma unroll
    for (int i = 0; i < 32; ++i) wv[i] = W[(size_t)(k0 + 2 * i + (lane >> 5)) * N + n0 + (lane & 31)];
    if (gain) {
#pragma unroll
        for (int i = 0; i < 32; ++i) wv[i] *= gain[k0 + 2 * i + (lane >> 5)];
    }
#pragma unroll
    for (int i = 0; i < 32; ++i) scr[(2 * i + (lane >> 5)) * 33 + (lane & 31)] = wv[i];
    asm volatile("s_waitcnt lgkmcnt(0)" ::: "memory");
    const int c = lane & 7;
#pragma unroll
    for (int j = 0; j < 4; ++j) { const int n = (lane >> 3) + 8 * j; const LAS float* s = scr + (8 * c) * 33 + n;
        u32x4 o; o.x = cvt_pk_bf16(s[0 * 33], s[1 * 33]); o.y = cvt_pk_bf16(s[2 * 33], s[3 * 33]); o.z = cvt_pk_bf16(s[4 * 33], s[5 * 33]); o.w = cvt_pk_bf16(s[6 * 33], s[7 * 33]);
        *(u32x4*)(WT + (size_t)(n0 + n) * ldk + k0 + 8 * c) = o; }
    asm volatile("s_waitcnt lgkmcnt(0)" ::: "memory");
}

__device__ __forceinline__ void sincos_acc(float a, float& c, float& s) {
    const double x = (double)a;
    const double q = __builtin_rint(x * 0.63661977236758134308);
    const double r = (x - q * 1.5707963267948966192) - q * 6.123233995736766e-17;
    const double r2 = r * r;
    double sp = 1.0 / 6227020800.0; sp = sp * r2 * (-1.0) + 1.0 / 39916800.0; sp = -sp * r2 + 1.0 / 362880.0; sp = -sp * r2 + 1.0 / 5040.0; sp = -sp * r2 + 1.0 / 120.0; sp = -sp * r2 + 1.0 / 6.0; sp = -sp * r2 + 1.0;
    const double sn = sp * r;
    double cp = 1.0 / 87178291200.0; cp = -cp * r2 + 1.0 / 479001600.0; cp = -cp * r2 + 1.0 / 3628800.0; cp = -cp * r2 + 1.0 / 40320.0; cp = -cp * r2 + 1.0 / 720.0; cp = -cp * r2 + 1.0 / 24.0; cp = -cp * r2 + 0.5; cp = -cp * r2 + 1.0;
    const int qi = ((int)q) & 3;
    double cc = (qi & 1) ? sn : cp, ss = (qi & 1) ? cp : sn;
    if (qi == 1 || qi == 2) cc = -cc;
    if (qi >= 2) ss = -ss;
    c = (float)cc; s = (float)ss;
}

__constant__ float c_inv_freq[16] = {
    1.0f, 0.440366596f, 0.193922743f, 0.0853971019f, 0.0376060307f, 0.0165604409f, 0.00729266461f, 0.00321144611f,
    0.00141421356f, 0.000622772437f, 0.000274248188f, 0.000120769735f, 5.31829573e-05f, 2.34199997e-05f, 1.03133852e-05f, 4.54167048e-06f};

__device__ __forceinline__ void phase_prep(const Params& p, LAS unsigned char* lds, int G, int bid) {
    const int tid = tid_fresh(), lane = tid & 63, wave = __builtin_amdgcn_readfirstlane(tid >> 6);
    unsigned char* ws = p.ws; unsigned char* dob = (unsigned char*)p.out;
    const int gw = bid * 8 + wave, NGW = G * 8;
    LAS float* scr = (LAS float*)(lds + wave * 16384);
    constexpr int I_IN = 16 * 240, I_A = 8 * 32, I_B = 8 * 32, I_O = 16 * 32, I_U = 16 * 128, I_D = 64 * 32;
    constexpr int NITEMS = I_IN + I_A + I_B + I_O + I_U + I_D;
    for (int it = gw; it < NITEMS; it += NGW) {
        int r = it;
        if (r < I_IN) { p0_transpose_item(p.in[2], 1024, DIN, (bf16_t*)(dob + DO_WIN), 1024, p.in[1], scr, r, lane); continue; } r -= I_IN;
        if (r < I_A) { p0_transpose_item(p.in[8], 512, 1024, (bf16_t*)(ws + WS_WAB), 512, nullptr, scr, r, lane); continue; } r -= I_A;
        if (r < I_B) { p0_transpose_item(p.in[9], 512, 1024, (bf16_t*)(ws + WS_WAB) + 1024 * 512, 512, nullptr, scr, r, lane); continue; } r -= I_B;
        if (r < I_O) { p0_transpose_item(p.in[10], 1024, 1024, (bf16_t*)(ws + WS_WOUT), 1024, nullptr, scr, r, lane); continue; } r -= I_O;
        if (r < I_U) { p0_transpose_item(p.in[13], 1024, FF, (bf16_t*)(ws + WS_WUP), 1024, p.in[12], scr, r, lane); continue; } r -= I_U;
        p0_transpose_item(p.in[14], FF, 1024, (bf16_t*)(ws + WS_WDOWN), FF, nullptr, scr, r, lane);
    }
    const float* x = p.in[0]; bf16_t* xb = (bf16_t*)(dob + DO_XB); float* rstd0 = (float*)(ws + WS_RSTD0);
    for (int m0 = gw; m0 < M; m0 += 4 * NGW) {
        f32x4 v[4][4];
#pragma unroll
        for (int i = 0; i < 4; ++i) { const int mm = (m0 + i * NGW < M) ? m0 + i * NGW : M - 1; const f32x4* xr = (const f32x4*)(x + (size_t)mm * D) + lane;
#pragma unroll
            for (int j = 0; j < 4; ++j) v[i][j] = __builtin_nontemporal_load(xr + 64 * j); }
#pragma unroll
        for (int i = 0; i < 4; ++i) { const int m = (m0 + i * NGW < M) ? m0 + i * NGW : M - 1; float s = 0.f;
#pragma unroll
            for (int j = 0; j < 4; ++j) s += (v[i][j][0] * v[i][j][0] + v[i][j][1] * v[i][j][1]) + (v[i][j][2] * v[i][j][2] + v[i][j][3] * v[i][j][3]);
            s = wave_sum(s);
            u32x2* o8 = (u32x2*)(xb + (size_t)m * D) + lane;
#pragma unroll
            for (int j = 0; j < 4; ++j) { u32x2 w; w.x = cvt_pk_bf16(v[i][j][0], v[i][j][1]); w.y = cvt_pk_bf16(v[i][j][2], v[i][j][3]); o8[64 * j] = w; }
            if (lane == 0) { const float rv = 1.0f / sqrtf(s * (1.0f / D) + EPS); rstd0[m] = rv; float* ru = (float*)(ws + WS_RSTDU);
                const int bb = m & ~(SEQ - 1), sq = m & (SEQ - 1);
                ru[m] = rv; ru[M + bb + ((sq & 3) << 9) + (sq >> 2)] = rv; ru[2 * M + bb + ((sq & 15) << 7) + (sq >> 4)] = rv; } }
    }
    const int gt = bid * 512 + tid, NGT = G * 512;
    { const float* wsp = p.in[6]; bf16_t* o = (bf16_t*)(ws + WS_WSP);
      for (int i = gt; i < 4 * 128 * 128 / 2; i += NGT) ((unsigned*)o)[i] = cvt_pk_bf16(wsp[2 * i], wsp[2 * i + 1]); }
    { float2* rope = (float2*)(ws + WS_ROPE);
      for (int i = gt; i < SEQ * 16; i += NGT) { const float ang = (float)(i >> 4) * c_inv_freq[i & 15]; float c, s; sincos_acc(ang, c, s); rope[i] = make_float2(c, s); } }
    { float* z = (float*)(ws + WS_SS1); for (int i = gt; i < 2 * M; i += NGT) z[i] = 0.f; }
}

__device__ __forceinline__ void gmlp_unit(const Params& p, LAS unsigned char* lds, int chunk) {
    const int tid = tid_fresh(), lane = tid & 63, wave = __builtin_amdgcn_readfirstlane(tid >> 6);
    bf16_t* Z = (bf16_t*)(p.ws + WS_Z);
    const bf16_t* WSP = (const bf16_t*)(p.ws + WS_WSP);
    const float* lng = p.in[4]; const float* lnb = p.in[5]; const float* bsp = p.in[7];
    LAS f32x2* part = (LAS f32x2*)(lds + 512 * VT_PITCH);
    const int s = tid & 127, cq = tid >> 7;
    const bf16_t* vrow = Z + (size_t)(chunk * 128 + s) * 1024 + 512 + cq * 128;
    {   float sm = 0.f, sq = 0.f;
#pragma unroll 4
        for (int j = 0; j < 16; ++j) { const u32x4 w = *(const u32x4*)(vrow + 8 * j);
            const float a0 = bf_lo(w.x), a1 = bf_hi(w.x), a2 = bf_lo(w.y), a3 = bf_hi(w.y), a4 = bf_lo(w.z), a5 = bf_hi(w.z), a6 = bf_lo(w.w), a7 = bf_hi(w.w);
            sm += ((a0 + a1) + (a2 + a3)) + ((a4 + a5) + (a6 + a7));
            sq += ((a0 * a0 + a1 * a1) + (a2 * a2 + a3 * a3)) + ((a4 * a4 + a5 * a5) + (a6 * a6 + a7 * a7)); }
        part[cq * 128 + s] = (f32x2){sm, sq};
    }
    __syncthreads();
    float mu, rstd;
    {   const f32x2 a = part[s], b = part[128 + s], c = part[256 + s], d = part[384 + s];
        const float sm = (a.x + b.x) + (c.x + d.x), sq = (a.y + b.y) + (c.y + d.y);
        mu = sm * (1.0f / 512.0f); const float var = fmaxf(sq * (1.0f / 512.0f) - mu * mu, 0.f); rstd = 1.0f / sqrtf(var + EPS); }
    {   LAS bf16_t* vt = (LAS bf16_t*)lds;
#pragma unroll 2
        for (int j = 0; j < 16; ++j) { const u32x4 w = *(const u32x4*)(vrow + 8 * j); const int c0 = cq * 128 + 8 * j;
            const float a[8] = {bf_lo(w.x), bf_hi(w.x), bf_lo(w.y), bf_hi(w.y), bf_lo(w.z), bf_hi(w.z), bf_lo(w.w), bf_hi(w.w)};
#pragma unroll
            for (int e = 0; e < 8; e += 2) { const float y0 = (a[e] - mu) * rstd * lng[c0 + e] + lnb[c0 + e], y1 = (a[e + 1] - mu) * rstd * lng[c0 + e + 1] + lnb[c0 + e + 1];
                const unsigned pk = cvt_pk_bf16(y0, y1);
                vt[(c0 + e) * (VT_PITCH / 2) + s] = (bf16_t)(pk & 0xffffu); vt[(c0 + e + 1) * (VT_PITCH / 2) + s] = (bf16_t)(pk >> 16); } }
    }
    __syncthreads();
    const int g = wave >> 1, fr = lane & 15, fq = lane >> 4;
    f32x4 acc[4][8];
#pragma unroll
    for (int ct = 0; ct < 4; ++ct)
#pragma unroll
        for (int tt = 0; tt < 8; ++tt) acc[ct][tt] = (f32x4){0.f, 0.f, 0.f, 0.f};
    const bf16_t* wg = WSP + (size_t)g * 128 * 128 + fr * 128 + fq * 8;
    const LAS unsigned char* va = lds + (wave * 64 + fr) * VT_PITCH + fq * 16;
#pragma unroll 1
    for (int ks = 0; ks < 4; ++ks) {
        bf16x8 af[4], bfr[8];
#pragma unroll
        for (int tt = 0; tt < 8; ++tt) bfr[tt] = *(const bf16x8*)(wg + tt * 16 * 128 + ks * 32);
#pragma unroll
        for (int ct = 0; ct < 4; ++ct) af[ct] = *(const LAS bf16x8*)(va + ct * 16 * VT_PITCH + ks * 64);
#pragma unroll
        for (int ct = 0; ct < 4; ++ct)
#pragma unroll
            for (int tt = 0; tt < 8; ++tt) acc[ct][tt] = __builtin_amdgcn_mfma_f32_16x16x32_bf16(af[ct], bfr[tt], acc[ct][tt], 0, 0, 0);
    }
#pragma unroll
    for (int tt = 0; tt < 8; ++tt) { const int t = 16 * tt + fr; const float bs = bsp[g * 128 + t]; bf16_t* zr = Z + (size_t)(chunk * 128 + t) * 1024 + wave * 64 + 4 * fq;
#pragma unroll
        for (int ct = 0; ct < 4; ++ct) { const u32x2 uw = *(const u32x2*)(zr + 16 * ct); const f32x4 a = acc[ct][tt];
            u32x2 o; o.x = cvt_pk_bf16(bf_lo(uw.x) * (a[0] + bs), bf_hi(uw.x) * (a[1] + bs)); o.y = cvt_pk_bf16(bf_lo(uw.y) * (a[2] + bs), bf_hi(uw.y) * (a[3] + bs));
            *(u32x2*)(zr + 16 * ct) = o; } }
    __syncthreads();
}

struct AttnPend { bf16_t* pog; float* plse; float lsev; };
__device__ __forceinline__ void attn_flush(const AttnPend& pd, const LAS unsigned char* ob, int lane, int i0, int i1) {
#pragma unroll
    for (int i = 0; i < 8; ++i) if (i >= i0 && i < i1) { const int row = i * 4 + (lane >> 4), ch = lane & 15;
        const u32x4 w = *(const LAS u32x4*)(ob + row * 272 + ch * 16);
        *(u32x4*)(pd.pog + row * 128 + ch * 8) = w; }
}
__device__ __forceinline__ void attn_block_unit(const Params& p, LAS unsigned char* lds, int bu, AttnPend& pd, int wave, int lane) {
    const bf16_t* Q = (const bf16_t*)(p.ws + WS_Q); const bf16_t* Kb = (const bf16_t*)(p.ws + WS_K); const bf16_t* VT = (const bf16_t*)(p.ws + WS_VT);
    bf16_t* OG = (bf16_t*)((unsigned char*)p.out + DO_OG); float* LSE = (float*)((unsigned char*)p.out + DO_LSE);
    const int bh = bu >> 3, qt0 = (bu & 7) * 8, hd = bh % 12, b = bh / 12;
    const int g = hd >> 2, lb = 11 - 2 * g, rsh = lb - 5;
    const int qt = qt0 + wave, up0 = qt * 32, myres = qt >> rsh;
    const int ql = lane & 31, h = lane >> 5;
    const int qls = (ql & 19) | ((ql & 4) << 1) | ((ql & 8) >> 1);
    const unsigned okx = (unsigned)(lane >> 4) * 256u + ((((unsigned)((lane & 15) ^ (lane >> 4))) ^ (4u * (unsigned)(wave & 3))) << 4) + (unsigned)wave * 1024u;
    const unsigned ovx = (unsigned)(lane >> 2) * 64u + (unsigned)(((lane & 3) ^ ((lane >> 4) & 3)) << 4) + (unsigned)wave * 1024u;
    const char* kbase = (const char*)(Kb + (size_t)bh * SEQ * 128); const char* vbase = (const char*)(VT + (size_t)bh * SEQ * 128);
#define ATT_DMA(bufo, kt_) do { const size_t _to = (size_t)(kt_) * 8192; \
        __builtin_amdgcn_global_load_lds((const unsigned*)(kbase + _to + okx), (LAS unsigned*)(lds + (bufo) + wave * 1024), 16, 0, 0); \
        __builtin_amdgcn_global_load_lds((const unsigned*)(vbase + _to + ovx), (LAS unsigned*)(lds + (bufo) + 8192 + wave * 1024), 16, 0, 0); } while (0)
    const int k0 = (qt0 >= 2) ? qt0 - 2 : 0, k1 = (qt0 + 9 <= 63) ? qt0 + 9 : 63;
    ATT_DMA(0, k0);
    bf16x8 qf[8];
    { const bf16_t* qp = Q + ((size_t)bh * SEQ + up0 + ql) * 128 + 8 * h;
#pragma unroll
      for (int ks = 0; ks < 8; ++ks) qf[ks] = *(const bf16x8*)(qp + 16 * ks); }
    f32x16 o[4];
#pragma unroll
    for (int dt = 0; dt < 4; ++dt)
#pragma unroll
        for (int e = 0; e < 16; ++e) o[dt][e] = 0.f;
    float mrun = -1e30f, lrun = 0.f;
    const int kx = qls & 15, vx = (ql >> 2) & 3;
#pragma unroll 1
    for (int kt = k0; kt <= k1; ++kt) {
        const int bo = ((kt - k0) & 1) * 16384;
        asm volatile("s_waitcnt vmcnt(0)" ::: "memory");
        __syncthreads();
        if (kt < k1) ATT_DMA(16384 - bo, kt + 1);
        if (pd.pog != nullptr && kt - k0 < 4) {
            const LAS unsigned char* ob = lds + 32768 + wave * (32 * 272); const int sidx = kt - k0;
            attn_flush(pd, ob, lane, 2 * sidx, 2 * sidx + 2);
            if (sidx == 0 && (lane >> 5) == 0) pd.plse[lane & 31] = pd.lsev;
        }
        const int t = kt - qt + 2;
        if (t < 0 || t > 4 || (kt >> rsh) != myres) continue;
        const LAS unsigned char* kl = lds + bo + qls * 256;
        const LAS unsigned char* vl = lds + bo + 8192 + ql * 64;
        bf16x8 kf[8], vf[4][2];
#pragma unroll
        for (int ks = 0; ks < 8; ++ks) kf[ks] = *(const LAS bf16x8*)(kl + (((2 * ks + h) ^ kx) << 4));
#pragma unroll
        for (int dt = 0; dt < 4; ++dt)
#pragma unroll
            for (int s2 = 0; s2 < 2; ++s2) vf[dt][s2] = *(const LAS bf16x8*)(vl + dt * 2048 + (((2 * s2 + h) ^ vx) << 4));
        f32x16 x;
#pragma unroll
        for (int e = 0; e < 16; ++e) x[e] = 0.f;
#pragma unroll
        for (int ks = 0; ks < 8; ++ks) x = __builtin_amdgcn_mfma_f32_32x32x16_bf16(kf[ks], qf[ks], x, 0, 0, 0);
        if (t == 0) {
#pragma unroll
            for (int e = 0; e < 16; ++e) { const int kr = 16 * (e >> 3) + 8 * h + (e & 7); if (kr < ql) x[e] = -1e30f; }
        }
        if (t == 4) {
#pragma unroll
            for (int e = 0; e < 16; ++e) { const int kr = 16 * (e >> 3) + 8 * h + (e & 7); if (kr > ql) x[e] = -1e30f; }
        }
        float mx = x[0];
#pragma unroll
        for (int e = 1; e < 16; ++e) mx = fmaxf(mx, x[e]);
        mx = fmaxf(mx, __shfl_xor(mx, 32));
        const float mnew = fmaxf(mrun, mx); const float alpha = __builtin_amdgcn_exp2f(mrun - mnew); mrun = mnew;
        float ps = 0.f;
#pragma unroll
        for (int e = 0; e < 16; ++e) { x[e] = __builtin_amdgcn_exp2f(x[e] - mnew); ps += x[e]; }
        lrun = lrun * alpha + ps;
#pragma unroll
        for (int dt = 0; dt < 4; ++dt)
#pragma unroll
            for (int e = 0; e < 16; ++e) o[dt][e] *= alpha;
        bf16x8 pf[2];
#pragma unroll
        for (int s2 = 0; s2 < 2; ++s2) { u32x4 w; w.x = cvt_pk_bf16(x[8 * s2 + 0], x[8 * s2 + 1]); w.y = cvt_pk_bf16(x[8 * s2 + 2], x[8 * s2 + 3]); w.z = cvt_pk_bf16(x[8 * s2 + 4], x[8 * s2 + 5]); w.w = cvt_pk_bf16(x[8 * s2 + 6], x[8 * s2 + 7]);
            pf[s2] = __builtin_bit_cast(bf16x8, w); }
#pragma unroll
        for (int dt = 0; dt < 4; ++dt)
#pragma unroll
            for (int s2 = 0; s2 < 2; ++s2) o[dt] = __builtin_amdgcn_mfma_f32_32x32x16_bf16(vf[dt][s2], pf[s2], o[dt], 0, 0, 0);
    }
#undef ATT_DMA
    const float ltot = lrun + __shfl_xor(lrun, 32); const float inv = 1.0f / ltot;
    const size_t orow0 = ((size_t)(g * 64 + b * 4 + (hd & 3)) * SEQ + up0);
    {   LAS unsigned char* ob = lds + 32768 + wave * (32 * 272);
#pragma unroll
        for (int dt = 0; dt < 4; ++dt)
#pragma unroll
            for (int c = 0; c < 4; ++c) { u32x2 w; w.x = cvt_pk_bf16(o[dt][4 * c] * inv, o[dt][4 * c + 1] * inv); w.y = cvt_pk_bf16(o[dt][4 * c + 2] * inv, o[dt][4 * c + 3] * inv);
                *(LAS u32x2*)(ob + ql * 272 + (dt * 32 + 8 * c + 4 * h) * 2) = w; }
        asm volatile("s_waitcnt lgkmcnt(0)" ::: "memory");
        pd.pog = OG + orow0 * 128; pd.plse = LSE + orow0; pd.lsev = mrun + __log2f(ltot);
    }
    asm volatile("s_waitcnt lgkmcnt(0)" ::: "memory");
    __syncthreads();
}

template <int R> __device__ __forceinline__ void combine_rows(const Params& p, int row0, int rstride, int lane) {
    const bf16_t* OG = (const bf16_t*)((unsigned char*)p.out + DO_OG); const float* LSE = (const float*)((unsigned char*)p.out + DO_LSE);
    bf16_t* Z = (bf16_t*)(p.ws + WS_Z);
    const int hg = lane >> 4;
    float l[R][3]; u32x4 v[R][3];
#pragma unroll
    for (int i = 0; i < R; ++i) { const int row = (row0 + i * rstride < M) ? row0 + i * rstride : M - 1; const int bb = row >> 11, sq = row & (SEQ - 1);
#pragma unroll
        for (int g = 0; g < 3; ++g) { const int uu = ((sq & ((1 << (2 * g)) - 1)) << (11 - 2 * g)) + (sq >> (2 * g)); const size_t orow = (size_t)(g * 64 + bb * 4 + hg) * SEQ + uu;
            l[i][g] = LSE[orow]; v[i][g] = *(const u32x4*)(OG + orow * 128 + 8 * (lane & 15)); } }
#pragma unroll
    for (int i = 0; i < R; ++i) { const int row = (row0 + i * rstride < M) ? row0 + i * rstride : M - 1;
        const float mx = fmaxf(l[i][0], fmaxf(l[i][1], l[i][2]));
        float w0 = __builtin_amdgcn_exp2f(l[i][0] - mx), w1 = __builtin_amdgcn_exp2f(l[i][1] - mx), w2 = __builtin_amdgcn_exp2f(l[i][2] - mx);
        const float inv = 1.0f / (w0 + w1 + w2); w0 *= inv; w1 *= inv; w2 *= inv;
        const u32x4 a = v[i][0], bq = v[i][1], c = v[i][2]; u32x4 o;
        o.x = cvt_pk_bf16(w0 * bf_lo(a.x) + w1 * bf_lo(bq.x) + w2 * bf_lo(c.x), w0 * bf_hi(a.x) + w1 * bf_hi(bq.x) + w2 * bf_hi(c.x));
        o.y = cvt_pk_bf16(w0 * bf_lo(a.y) + w1 * bf_lo(bq.y) + w2 * bf_lo(c.y), w0 * bf_hi(a.y) + w1 * bf_hi(bq.y) + w2 * bf_hi(c.y));
        o.z = cvt_pk_bf16(w0 * bf_lo(a.z) + w1 * bf_lo(bq.z) + w2 * bf_lo(c.z), w0 * bf_hi(a.z) + w1 * bf_hi(bq.z) + w2 * bf_hi(c.z));
        o.w = cvt_pk_bf16(w0 * bf_lo(a.w) + w1 * bf_lo(bq.w) + w2 * bf_lo(c.w), w0 * bf_hi(a.w) + w1 * bf_hi(bq.w) + w2 * bf_hi(c.w));
        *(u32x4*)(Z + (size_t)row * 1024 + 512 + 8 * lane) = o; }
}

template <int R> __device__ __forceinline__ void h1_rows(const Params& p, int row0, int rstride, int lane) {
    const float* x = p.in[0]; const float* g1 = p.in[11];
    const bf16_t* MIX = (const bf16_t*)(p.ws + WS_MIX); const float* ss1 = (const float*)(p.ws + WS_SS1);
    bf16_t* H1B = (bf16_t*)(p.ws + WS_H1B); float* e2 = (float*)(p.ws + WS_E2);
    f32x4 xv[R][4]; u32x2 mw[R][4]; float r1[R];
#pragma unroll
    for (int i = 0; i < R; ++i) { const int row = (row0 + i * rstride < M) ? row0 + i * rstride : M - 1; r1[i] = ss1[row];
        const f32x4* xr = (const f32x4*)(x + (size_t)row * D) + lane; const u32x2* mr = (const u32x2*)(MIX + (size_t)row * D) + lane;
#pragma unroll
        for (int j = 0; j < 4; ++j) { xv[i][j] = __builtin_nontemporal_load(xr + 64 * j); mw[i][j] = mr[64 * j]; } }
    f32x4 gv[4];
#pragma unroll
    for (int j = 0; j < 4; ++j) gv[j] = ((const f32x4*)g1 + lane)[64 * j];
#pragma unroll
    for (int i = 0; i < R; ++i) { const int row = (row0 + i * rstride < M) ? row0 + i * rstride : M - 1; const float rr = 1.0f / sqrtf(r1[i] * (1.0f / D) + EPS);
        u32x2* o8 = (u32x2*)(H1B + (size_t)row * D) + lane; float s = 0.f;
#pragma unroll
        for (int j = 0; j < 4; ++j) {
            const float h0 = xv[i][j][0] + bf_lo(mw[i][j].x) * rr * gv[j][0], h1 = xv[i][j][1] + bf_hi(mw[i][j].x) * rr * gv[j][1], h2 = xv[i][j][2] + bf_lo(mw[i][j].y) * rr * gv[j][2], h3 = xv[i][j][3] + bf_hi(mw[i][j].y) * rr * gv[j][3];
            s += (h0 * h0 + h1 * h1) + (h2 * h2 + h3 * h3);
            u32x2 w; w.x = cvt_pk_bf16(h0, h1); w.y = cvt_pk_bf16(h2, h3); o8[64 * j] = w; }
        s = wave_sum(s);
        if (lane == 0) { const float t = s * (1.0f / D) + EPS; e2[row] = EPS * t * t; } }
}
template <int R> __device__ __forceinline__ void final_rows(const Params& p, int row0, int rstride, int lane) {
    const float* g3 = p.in[15];
    const bf16_t* H1B = (const bf16_t*)(p.ws + WS_H1B); const bf16_t* MLP = (const bf16_t*)(p.ws + WS_MLP);
    const float* ss2 = (const float*)(p.ws + WS_SS2); const float* e2 = (const float*)(p.ws + WS_E2);
    u32x2 hw[R][4], lw[R][4]; float a2[R], a3[R];
#pragma unroll
    for (int i = 0; i < R; ++i) { const int row = (row0 + i * rstride < M) ? row0 + i * rstride : M - 1; a2[i] = ss2[row]; a3[i] = e2[row];
        const u32x2* hr = (const u32x2*)(H1B + (size_t)row * D) + lane; const u32x2* lr = (const u32x2*)(MLP + (size_t)row * D) + lane;
#pragma unroll
        for (int j = 0; j < 4; ++j) { hw[i][j] = hr[64 * j]; lw[i][j] = lr[64 * j]; } }
    f32x4 gc[4];
#pragma unroll
    for (int j = 0; j < 4; ++j) gc[j] = ((const f32x4*)g3 + lane)[64 * j];
#pragma unroll
    for (int i = 0; i < R; ++i) { const int row = (row0 + i * rstride < M) ? row0 + i * rstride : M - 1;
        const float r3 = 1.0f / sqrtf(a2[i] * (1.0f / D) + a3[i]);
        f32x4* orow = (f32x4*)(p.out + (size_t)row * D) + lane;
#pragma unroll
        for (int j = 0; j < 4; ++j) { f32x4 ov;
            ov[0] = bf_lo(hw[i][j].x) + bf_lo(lw[i][j].x) * r3 * gc[j][0];
            ov[1] = bf_hi(hw[i][j].x) + bf_hi(lw[i][j].x) * r3 * gc[j][1];
            ov[2] = bf_lo(hw[i][j].y) + bf_lo(lw[i][j].y) * r3 * gc[j][2];
            ov[3] = bf_hi(hw[i][j].y) + bf_hi(lw[i][j].y) * r3 * gc[j][3];
            __builtin_nontemporal_store(ov, orow + 64 * j); } }
}

#define XB_TMO      128
#define XB_XCNT(j)  (256  + 64 * (j))
#define XB_XSUB(j)  (1280 + 64 * (j))
#define XB_XGEN(j)  (2304 + 64 * (j))
#define XB_TOP      3328
#define XB_TOPGEN   3392
#define XCD_BAR_WORDS 3456
#define XB_SPIN_CAP (1u << 18)

__device__ __forceinline__ unsigned xb_ld(unsigned* p)              { return __hip_atomic_load(p, __ATOMIC_RELAXED, __HIP_MEMORY_SCOPE_AGENT); }
__device__ __forceinline__ unsigned xb_add(unsigned* p, unsigned v) { return __hip_atomic_fetch_add(p, v, __ATOMIC_RELAXED, __HIP_MEMORY_SCOPE_AGENT); }
__device__ __forceinline__ unsigned xb_xcc_id() { return (unsigned)__builtin_amdgcn_s_getreg((3 << 11) | 20) & 0xFu; }
#define XB_SPIN(cond, bar) do { unsigned _sp = 0; while (cond) { __builtin_amdgcn_s_sleep(1); \
    if ((++_sp & 255u) == 0u) { if (xb_ld(&(bar)[XB_TMO])) break; if (_sp > XB_SPIN_CAP) { atomicAdd(&(bar)[XB_TMO], 1u); break; } } } } while (0)

struct XcdBarrier {
    unsigned* bar; unsigned x;
    volatile LAS unsigned* st;
};

__device__ __forceinline__ XcdBarrier xcd_barrier_post(unsigned* bar, volatile LAS unsigned* st) {
    XcdBarrier b; b.bar = bar; b.x = xb_xcc_id(); b.st = st;
    if (threadIdx.x == 0) (void)xb_add(&bar[XB_XCNT(b.x)], 1u);
    return b;
}
__device__ __forceinline__ void xcd_barrier_complete(unsigned* bar, unsigned x, unsigned& nloc, unsigned& nx) {
    const unsigned G = gridDim.x * gridDim.y * gridDim.z;
    unsigned sum, cnt, mine, sp = 0u;
    for (;;) {
        sum = 0u; cnt = 0u; mine = 0u;
#pragma unroll
        for (unsigned j = 0; j < 16; ++j) { const unsigned c = xb_ld(&bar[XB_XCNT(j)]); sum += c; cnt += (c > 0u) ? 1u : 0u; mine = (j == x) ? c : mine; }
        if (sum == G) break;
        __builtin_amdgcn_s_sleep(1);
        if ((++sp & 255u) == 0u) { if (xb_ld(&bar[XB_TMO])) break; if (sp > XB_SPIN_CAP) { atomicAdd(&bar[XB_TMO], 1u); break; } }
    }
    nloc = mine > 0u ? mine : 1u; nx = cnt > 0u ? cnt : 1u;
}

__device__ __forceinline__ void xcd_barrier(const XcdBarrier& b) {
    asm volatile("s_waitcnt vmcnt(0)" ::: "memory");
    __syncthreads();
    if (threadIdx.x == 0) {
        unsigned* bar = b.bar;
        __builtin_amdgcn_s_waitcnt(0);
        unsigned nloc = b.st[0], nx = b.st[1];
        if (nloc == 0u) { xcd_barrier_complete(bar, b.x, nloc, nx); b.st[0] = nloc; b.st[1] = nx; }
        const unsigned old = xb_add(&bar[XB_XSUB(b.x)], 1u);
        const unsigned gen = old / nloc;
        if (old + 1u == (gen + 1u) * nloc) {
            __builtin_amdgcn_fence(__ATOMIC_RELEASE, "agent");
            asm volatile("s_waitcnt vmcnt(0)" ::: "memory");
            const unsigned og = xb_add(&bar[XB_TOP], 1u);
            const unsigned tg = og / nx;
            if (og + 1u == (tg + 1u) * nx) xb_add(&bar[XB_TOPGEN], 1u);
            else XB_SPIN(xb_ld(&bar[XB_TOPGEN]) == tg, bar);
            __builtin_amdgcn_fence(__ATOMIC_ACQUIRE, "agent");
            xb_add(&bar[XB_XGEN(b.x)], 1u);
            asm volatile("s_waitcnt vmcnt(0)" ::: "memory");
        } else {
            XB_SPIN(xb_ld(&bar[XB_XGEN(b.x)]) == gen, bar);
            __builtin_amdgcn_fence(__ATOMIC_ACQUIRE, "agent");
            asm volatile("s_waitcnt vmcnt(0)" ::: "memory");
        }
    }
    __syncthreads();
}


#ifndef MK_MULTI
#define MK_MULTI 0
#endif

#ifndef PH_MASK
#define PH_MASK 0x3ff
#endif
__device__ __forceinline__ int tid_fresh() { int t = threadIdx.x; asm volatile("" : "+v"(t)); return t; }
template <int ph> __device__ __forceinline__ void run_phase(LAS unsigned char* lds, int G, int bid) {
    if constexpr (ph < 10 && !((PH_MASK >> ph) & 1)) return;
    const Params p = load_params();
    const int tid = tid_fresh(), lane = tid & 63, wave = __builtin_amdgcn_readfirstlane(tid >> 6);
    unsigned char* ws = p.ws; unsigned char* dob = (unsigned char*)p.out;
    if constexpr (ph == 0) { phase_prep(p, lds, G, bid); }
    else if constexpr (ph == 1) {
        { pg8::Gemm g{(const bf16_t*)(dob + DO_XB), (const bf16_t*)(dob + DO_WIN), 1024, 1024, 1024, 0, 1}; pg8::InOrder S; S.init(M, G, bid);
          pg8::EpiIn E{(const float*)(ws + WS_RSTD0), (bf16_t*)(ws + WS_Z), (bf16_t*)(ws + WS_Q), (bf16_t*)(ws + WS_K), (bf16_t*)(ws + WS_G), p.in[3], (const float2*)(ws + WS_ROPE)};
          pg8::gemm_phase<pg8::EpiIn, pg8::InOrder, true, true>(lds, g, S, E); }
#pragma unroll 1
        for (int hg = 0; hg < 3; ++hg) {
            pg8::Gemm g{(const bf16_t*)(dob + DO_WIN) + (size_t)4096 * 1024, (const bf16_t*)(dob + DO_XB), 1024, 1024, 1024, hg == 2 ? 2 : 1, 1 << (2 * hg)}; pg8::VtOrder S; S.init(hg, G, bid);
            pg8::EpiVT E{(const float*)(ws + WS_RSTDU), (bf16_t*)(ws + WS_VT), hg};
            pg8::gemm_phase<pg8::EpiVT, pg8::VtOrder, true, true>(lds, g, S, E);
        }
    } else if constexpr (ph == 2 || ph == 12) {
        if constexpr (ph == 2) for (int c = bid; c < M / 128; c += G) gmlp_unit(p, lds, c);
        { AttnPend pd; pd.pog = nullptr; pd.plse = nullptr; pd.lsev = 0.f;
          for (int u = bid; u < NB * 12 * 8; u += G) attn_block_unit(p, lds, u, pd, wave, lane);
          if (pd.pog != nullptr) { attn_flush(pd, lds + 32768 + wave * (32 * 272), lane, 0, 8); if ((lane >> 5) == 0) pd.plse[lane & 31] = pd.lsev; }
          asm volatile("s_waitcnt lgkmcnt(0)" ::: "memory"); __syncthreads(); }
    } else if constexpr (ph == 3) {
        for (int m = bid * 8 + wave; m < M; m += G * 8 * 2) combine_rows<2>(p, m, G * 8, lane);
    } else if constexpr (ph == 4) {
        pg8::Gemm g{(const bf16_t*)(ws + WS_Z), (const bf16_t*)(ws + WS_WAB), 1024, 512, 512, 0, 1}; pg8::TwoPartOrder S; S.init(M, 1024, G, bid);
        pg8::EpiMerge E{(const bf16_t*)(ws + WS_G), (bf16_t*)(ws + WS_MERGED)};
        pg8::gemm_phase<pg8::EpiMerge, pg8::TwoPartOrder, true, true>(lds, g, S, E);
    } else if constexpr (ph == 5) {
        pg8::Gemm g{(const bf16_t*)(ws + WS_MERGED), (const bf16_t*)(ws + WS_WOUT), 1024, 1024, 1024, 0, 1}; pg8::StaticOrder S; S.init(M, 1024, G, bid);
        pg8::EpiStore<0, true> E{(bf16_t*)(ws + WS_MIX), 1024, (float*)(ws + WS_SS1)};
        pg8::gemm_phase<pg8::EpiStore<0, true>, pg8::StaticOrder, true, true>(lds, g, S, E);
    } else if constexpr (ph == 6) {
        for (int m = bid * 8 + wave; m < M; m += G * 8 * 2) h1_rows<2>(p, m, G * 8, lane);
    } else if constexpr (ph == 7) {
        pg8::Gemm g{(const bf16_t*)(ws + WS_H1B), (const bf16_t*)(ws + WS_WUP), 1024, 1024, 1024, 0, 1}; pg8::StaticOrder S; S.init(M, FF, G, bid);
        pg8::EpiStore<1, false> E{(bf16_t*)(ws + WS_HID), FF, nullptr};
        pg8::gemm_phase<pg8::EpiStore<1, false>, pg8::StaticOrder, true, true>(lds, g, S, E);
    } else if constexpr (ph == 8) {
        pg8::Gemm g{(const bf16_t*)(ws + WS_HID), (const bf16_t*)(ws + WS_WDOWN), FF, FF, FF, 0, 1}; pg8::StaticOrder S; S.init(M, 1024, G, bid);
        pg8::EpiStore<0, true> E{(bf16_t*)(ws + WS_MLP), 1024, (float*)(ws + WS_SS2)};
        pg8::gemm_phase<pg8::EpiStore<0, true>, pg8::StaticOrder, true, true>(lds, g, S, E);
    } else {
        for (int m = bid * 8 + wave; m < M; m += G * 8 * 2) final_rows<2>(p, m, G * 8, lane);
    }
}
constexpr int NPHASE = 10;

#if MK_MULTI
template <int PH> __global__ void __launch_bounds__(512, 2) fwd_phase(Params p) {
    extern __shared__ __attribute__((aligned(16))) unsigned char lds_raw[];
    run_phase<PH>((LAS unsigned char*)lds_raw, (int)gridDim.x, (int)blockIdx.x);
}
#else
__global__ void __launch_bounds__(512, 2) fwd_mega(Params p) {
    extern __shared__ __attribute__((aligned(16))) unsigned char lds_raw[];
    LAS unsigned char* lds = (LAS unsigned char*)lds_raw;
    cg::grid_group grid = cg::this_grid();
    const int G = (int)gridDim.x, bid = (int)blockIdx.x;
#define SEAM() do { __syncthreads(); grid.sync(); } while (0)
    volatile LAS unsigned* bst = (volatile LAS unsigned*)(lds + LDS_BYTES - 16);
    if (threadIdx.x == 0) { bst[0] = 0u; bst[1] = 0u; }
    __syncthreads();
    XcdBarrier xbar; xbar.bar = (unsigned*)(load_params().ws + WS_BAR); xbar.x = 0; xbar.st = bst;
    if (bid == 0) for (int i = threadIdx.x; i < 4096; i += 512) __hip_atomic_store(xbar.bar + i, 0u, __ATOMIC_RELAXED, __HIP_MEMORY_SCOPE_AGENT);
#define SEAMK(k) xcd_barrier(xbar)
#ifndef REP_MASK
#define REP_MASK 0
#endif
#define REP(k) do { if constexpr ((REP_MASK >> (k)) & 1) { run_phase<((k) == 2 ? 12 : (k))>(lds, G, bid); SEAM(); } } while (0)
    run_phase<0>(lds, G, bid); SEAM(); xbar = xcd_barrier_post(xbar.bar, bst); REP(0);
    run_phase<1>(lds, G, bid); SEAMK(1); REP(1);
    run_phase<2>(lds, G, bid); SEAMK(2); REP(2);
    run_phase<3>(lds, G, bid); SEAMK(3); REP(3);
    run_phase<4>(lds, G, bid); SEAMK(4); REP(4);
    run_phase<5>(lds, G, bid); SEAMK(5);
    run_phase<6>(lds, G, bid); SEAMK(6); REP(6);
    run_phase<7>(lds, G, bid); SEAMK(7); REP(7);
    run_phase<8>(lds, G, bid); SEAMK(8);
    run_phase<9>(lds, G, bid);
#undef SEAM
}
#endif

extern "C" void kernel_launch(void* const* d_in, const int* in_sizes, int n_in, void* d_out, int out_size, void* d_ws, size_t ws_size, hipStream_t stream) {
    static int grid = 0;
    if (grid == 0) {
        if (n_in != 16 || in_sizes[0] != M * D || out_size != M * D || ws_size < WS_NEED) { fprintf(stderr, "kernel_launch: unexpected shapes: n_in %d in0 %d out %d ws %zu (need %zu)\n", n_in, n_in > 0 ? in_sizes[0] : -1, out_size, ws_size, (size_t)WS_NEED); grid = -1; return; }
        int dev = 0, cus = 0, per_cu = 0;
        (void)hipGetDevice(&dev); (void)hipDeviceGetAttribute(&cus, hipDeviceAttributeMultiprocessorCount, dev);
#if MK_MULTI
        const void* fn = (const void*)fwd_phase<1>;
#else
        const void* fn = (const void*)fwd_mega;
#endif
        if (hipFuncSetAttribute(fn, hipFuncAttributeMaxDynamicSharedMemorySize, LDS_BYTES) != hipSuccess) { fprintf(stderr, "kernel_launch: hipFuncSetAttribute failed\n"); grid = -1; return; }
        if (hipOccupancyMaxActiveBlocksPerMultiprocessor(&per_cu, fn, 512, LDS_BYTES) != hipSuccess || per_cu < 1) { fprintf(stderr, "kernel_launch: occupancy query gave %d\n", per_cu); per_cu = 1; }
        (void)hipGetLastError();
        grid = cus * per_cu;
    }
    if (grid < 0) return;
    Params p{};
    for (int i = 0; i < 16; ++i) p.in[i] = (const float*)d_in[i];
    p.out = (float*)d_out; p.ws = (unsigned char*)d_ws;
#if MK_MULTI
#define LP(k) do { (void)hipFuncSetAttribute((const void*)fwd_phase<k>, hipFuncAttributeMaxDynamicSharedMemorySize, LDS_BYTES); hipLaunchKernelGGL(fwd_phase<k>, dim3(grid), dim3(512), LDS_BYTES, stream, p); } while (0)
    LP(0); LP(1); LP(2); LP(3); LP(4); LP(5); LP(6); LP(7); LP(8); LP(9);
#undef LP
#else
    void* args[] = {&p};
    hipError_t e = hipLaunchCooperativeKernel((const void*)fwd_mega, dim3(grid), dim3(512), args, LDS_BYTES, stream);
    if (e != hipSuccess) fprintf(stderr, "kernel_launch: cooperative launch failed: %s (grid %d)\n", hipGetErrorString(e), grid);
#endif
}
```

```cpp
#include <hip/hip_runtime.h>
#include <hip/hip_cooperative_groups.h>
#include <cstdio>
#include <cstdint>
namespace cg = cooperative_groups;

#define LAS __attribute__((address_space(3)))
typedef unsigned short bf16_t;
typedef short bf16x8 __attribute__((ext_vector_type(8)));
typedef float f32x4 __attribute__((ext_vector_type(4)));
typedef float f32x16 __attribute__((ext_vector_type(16)));
typedef unsigned u32x4 __attribute__((ext_vector_type(4)));
typedef unsigned u32x2 __attribute__((ext_vector_type(2)));
typedef float f32x2 __attribute__((ext_vector_type(2)));

constexpr int NB = 16, SEQ = 2048, M = NB * SEQ, D = 1024, DIN = 7680, FF = 4096;
constexpr float EPS = 1e-6f;
constexpr size_t MiB = (size_t)1 << 20;
constexpr size_t WS_Z = 0;
constexpr size_t WS_Q = 64 * MiB;
constexpr size_t WS_K = 160 * MiB;
constexpr size_t WS_VT = 256 * MiB;
constexpr size_t WS_G = 352 * MiB;
constexpr size_t WS_WAB = 480 * MiB;
constexpr size_t WS_WOUT = 482 * MiB;
constexpr size_t WS_WUP = 484 * MiB;
constexpr size_t WS_WDOWN = 492 * MiB;
constexpr size_t WS_WSP = 500 * MiB;
constexpr size_t WS_ROPE = 501 * MiB;
constexpr size_t WS_RSTD0 = 502 * MiB;
constexpr size_t WS_SS1 = WS_RSTD0 + 131072;
constexpr size_t WS_SS2 = WS_SS1 + 131072;
constexpr size_t WS_E2 = WS_SS2 + 131072;
constexpr size_t WS_RSTDU = WS_E2 + 131072;
constexpr size_t WS_BAR = 503 * MiB;
constexpr size_t WS_NEED = 504 * MiB;
constexpr size_t WS_YB = 160 * MiB;
constexpr size_t WS_MERGED = 64 * MiB;
constexpr size_t WS_MIX = 128 * MiB;
constexpr size_t WS_H1B = 0;
constexpr size_t WS_HID = 192 * MiB;
constexpr size_t WS_MLP = 64 * MiB;
constexpr size_t DO_XB = 0;
constexpr size_t DO_WIN = 64 * MiB;
constexpr size_t DO_OG = 0;
constexpr size_t DO_LSE = 96 * MiB;

constexpr int LDS_BYTES = 147456;
constexpr int VT_PITCH = 272;

__device__ __forceinline__ unsigned cvt_pk_bf16(float lo, float hi) { unsigned r; asm volatile("v_cvt_pk_bf16_f32 %0, %1, %2" : "=v"(r) : "v"(lo), "v"(hi)); return r; }
__device__ __forceinline__ float bf_lo(unsigned w) { return __uint_as_float(w << 16); }
__device__ __forceinline__ float bf_hi(unsigned w) { return __uint_as_float(w & 0xffff0000u); }
__device__ __forceinline__ float wave_sum(float v) {
#pragma unroll
    for (int o = 1; o < 64; o <<= 1) v += __shfl_xor(v, o);
    return v;
}

__device__ __forceinline__ int tid_fresh();
namespace pg8 {
constexpr int BM = 256, BK = 64, HALF = 128, HTB = HALF * BK * 2, STAGE_BYTES = 8 * HTB, NXCD = 8, WGM = 8;
__host__ __device__ __forceinline__ int lds_byte(int r, int c) { const int st = (r >> 4) * 2 + (c >> 5), rr = r & 15, cc = c & 31, ob = rr * 64 + cc * 2; return st * 1024 + (ob ^ (((ob >> 9) & 1) << 5)); }
__host__ __device__ __forceinline__ void stage_rc(int b, int& R, int& C) { const int st = b / 1024, sb = b % 1024, swz = sb ^ (((sb >> 9) & 1) << 5); R = (st >> 1) * 16 + swz / 64; C = (st & 1) * 32 + (swz % 64) / 2; }
__host__ __device__ __forceinline__ int perm32(int rho) { const int n = rho >> 4, i = rho & 15; return 8 * (i >> 2) + 4 * n + (i & 3); }

struct Unit { int pm, pn; unsigned aoff, boff; int part; };
struct Gemm { const bf16_t* A; const bf16_t* Bt; int lda, ldb, K; int bmode, bd; };
__device__ __forceinline__ int rowmapB(int R, int bmode, int bd) { return bmode == 0 ? R : (bmode == 1 ? R * bd : ((R & 127) * 16 + (R >> 7))); }

__device__ __forceinline__ void tile_of(int L, int nM, int nN, int& pm, int& pn) {
    const int nwg = nM * nN; int wgid = L;
    { const int q = nwg / NXCD, r = nwg % NXCD, xcd = wgid % NXCD, off = wgid / NXCD; wgid = (xcd < r ? xcd * (q + 1) : r * (q + 1) + (xcd - r) * q) + off; }
    const int nig = WGM * nN, gid = wgid / nig, fm = gid * WGM, gsz = (nM - fm) < WGM ? (nM - fm) : WGM;
    pm = fm + ((wgid % nig) % gsz); pn = (wgid % nig) / gsz;
}
struct StaticOrder {
    int nM, nN, nwg, G, c;
    __device__ __forceinline__ void init(int M_, int N_, int G_, int c_) { nM = M_ / BM; nN = N_ / BM; nwg = nM * nN; G = G_; c = c_; }
    __device__ __forceinline__ bool next(int i, Unit& u) const {
        const long L = (long)i * G + c; if (L >= nwg) return false;
        tile_of((int)L, nM, nN, u.pm, u.pn); u.aoff = 0; u.boff = 0; u.part = 0; return true;
    }
};
struct InOrder {
    int nM, nN, nwg, G, c;
    __device__ __forceinline__ void init(int M_, int G_, int c_) { nM = M_ / BM; nN = 24; nwg = nM * nN; G = G_; c = c_; }
    __device__ __forceinline__ bool next(int i, Unit& u) const {
        const long L = (long)i * G + c; if (L >= nwg) return false;
        tile_of((int)L, nM, nN, u.pm, u.pn); if (u.pn >= 16) u.pn += 6; u.aoff = 0; u.boff = 0; u.part = 0; return true;
    }
};
struct VtOrder {
    int g, G, c;
    __device__ __forceinline__ void init(int g_, int G_, int c_) { g = g_; G = G_; c = c_; }
    __device__ __forceinline__ bool next(int i, Unit& u) const {
        const int L = i * G + c; if (L >= 256) return false;
        u.pm = 2 * g + (L & 1); u.pn = L >> 1;
        const int b = u.pn >> 3, t8 = u.pn & 7; int row0;
        if (g == 2) row0 = b * 2048 + 2 * t8;
        else { const int shift = 2 * g, lb = 11 - shift, u0 = t8 * 256; row0 = b * 2048 + ((u0 & ((1 << lb) - 1)) << shift) + (u0 >> lb); }
        u.aoff = 0; u.boff = (unsigned)row0 * 2048u; u.part = 0; return true;
    }
};
struct TwoPartOrder {
    int nM, nN, nwg, G, c;
    __device__ __forceinline__ void init(int M_, int N_, int G_, int c_) { nM = M_ / BM; nN = N_ / BM; nwg = nM * nN; G = G_; c = c_; }
    __device__ __forceinline__ bool next(int i, Unit& u) const {
        const long L = (long)(i >> 1) * G + c; if (L >= nwg) return false;
        tile_of((int)L, nM, nN, u.pm, u.pn);
        if (i & 1) { u.aoff = (unsigned)(WS_YB - WS_Z); u.boff = 1024u * 512u * 2u; u.part = 2; } else { u.aoff = 0; u.boff = 0; u.part = 1; }
        return true;
    }
};

template <class Epi, class Sched, bool ALIGN_EPI, bool SP2>
__device__ __forceinline__ void gemm_phase(LAS unsigned char* lds, const Gemm g, const Sched& S, const Epi& E) {
    const int tid = tid_fresh(), wid = __builtin_amdgcn_readfirstlane(tid >> 6), lane = tid & 63, wr = wid >> 2, wc = wid & 3, fr = lane & 15, fq = lane >> 4;
    const int K = g.K, nt = K / BK;
    unsigned voffA[2], voffB[2];
#pragma unroll
    for (int i = 0; i < 2; ++i) { int R, C; stage_rc(tid * 16 + i * 8192, R, C); const int Rb = Epi::PERM ? ((R & ~31) + perm32(R & 31)) : R;
        voffA[i] = (unsigned)(R * g.lda + C) * 2u; voffB[i] = (unsigned)(rowmapB(Rb, g.bmode, g.bd) * g.ldb + C) * 2u; }
    const size_t kstep = (size_t)(BK * 2);
    const size_t hstepA = (size_t)HALF * g.lda * 2, hstepB = (size_t)rowmapB(HALF, g.bmode, g.bd) * g.ldb * 2;
    const size_t tstepA = 2 * hstepA, tstepB = g.bmode ? (size_t)0 : 2 * hstepB;
    const unsigned ldsw = (unsigned)wid * 1024u;
    const int aoff = lds_byte(wr * 64 + fr, fq * 8), boff = lds_byte(wc * 32 + fr, fq * 8);
#define PG8_SA(b, h) (((b) * 2 + (h)) * HTB)
#define PG8_SB(b, h) ((4 + (b) * 2 + (h)) * HTB)
#define PG8_STAGE(bufoff, gbase, voff) do { _Pragma("unroll") for (int _i = 0; _i < 2; ++_i) \
        __builtin_amdgcn_global_load_lds((const unsigned*)((const char*)(gbase) + (voff)[_i]), (LAS unsigned*)(lds + (bufoff) + ldsw + _i * 8192), 16, 0, 0); } while (0)
#define PG8_LDA(dst, b, h) do { _Pragma("unroll") for (int m = 0; m < 4; ++m) _Pragma("unroll") for (int k = 0; k < 2; ++k) dst[m][k] = *(const LAS bf16x8*)(lds + PG8_SA(b, h) + aoff + m * 2048 + k * 1024); } while (0)
#define PG8_LDB(dst, b, h) do { _Pragma("unroll") for (int n = 0; n < 2; ++n) _Pragma("unroll") for (int k = 0; k < 2; ++k) dst[n][k] = *(const LAS bf16x8*)(lds + PG8_SB(b, h) + boff + n * 2048 + k * 1024); } while (0)
#define PG8_MMA(ai, bj, At, Bt) do { __builtin_amdgcn_s_setprio(1); _Pragma("unroll") for (int m = 0; m < 4; ++m) _Pragma("unroll") for (int n = 0; n < 2; ++n) _Pragma("unroll") for (int k = 0; k < 2; ++k) \
        acc[ai][bj][m][n] = __builtin_amdgcn_mfma_f32_16x16x32_bf16(Bt[n][k], At[m][k], acc[ai][bj][m][n], 0, 0, 0); __builtin_amdgcn_s_setprio(0); } while (0)
#define PG8_WAIT_V(n) asm volatile("s_waitcnt vmcnt(" #n ")" ::: "memory")
#define PG8_WAIT_L(n) asm volatile("s_waitcnt lgkmcnt(" #n ")" ::: "memory")
#define PG8_BAR __builtin_amdgcn_s_barrier()
#define PG8_SCHED __builtin_amdgcn_sched_barrier(0)
    Unit cur, nxt; int ui = 0;
    if (!S.next(0, cur)) return;
    f32x4 acc[2][2][4][2];
#pragma unroll
    for (int a = 0; a < 2; ++a)
#pragma unroll
        for (int b = 0; b < 2; ++b)
#pragma unroll
            for (int m = 0; m < 4; ++m)
#pragma unroll
                for (int n = 0; n < 2; ++n) acc[a][b][m][n] = (f32x4){0.f, 0.f, 0.f, 0.f};
    bf16x8 At[4][2], B0[2][2], B1[2][2];
    const char* cA = (const char*)g.A + (size_t)cur.pm * tstepA + cur.aoff; const char* cB = (const char*)g.Bt + (size_t)cur.pn * tstepB + cur.boff;
    if constexpr (SP2) {
        PG8_STAGE(PG8_SB(0, 0), cB, voffB); PG8_STAGE(PG8_SB(0, 1), cB + hstepB, voffB); PG8_STAGE(PG8_SA(0, 0), cA, voffA); PG8_STAGE(PG8_SA(0, 1), cA + hstepA, voffA);
        if (wr == 1) PG8_BAR;
        PG8_WAIT_V(2); PG8_BAR;
        PG8_STAGE(PG8_SB(1, 0), cB + kstep, voffB); PG8_STAGE(PG8_SA(1, 0), cA + kstep, voffA); PG8_STAGE(PG8_SB(1, 1), cB + hstepB + kstep, voffB);
        PG8_WAIT_V(6); PG8_BAR;
    } else {
        PG8_STAGE(PG8_SB(0, 0), cB, voffB); PG8_STAGE(PG8_SA(0, 0), cA, voffA); PG8_STAGE(PG8_SB(0, 1), cB + hstepB, voffB); PG8_STAGE(PG8_SA(0, 1), cA + hstepA, voffA);
        if (wr == 1) PG8_BAR;
        PG8_WAIT_V(4); PG8_BAR;
        PG8_STAGE(PG8_SB(1, 0), cB + kstep, voffB); PG8_STAGE(PG8_SA(1, 0), cA + kstep, voffA); PG8_STAGE(PG8_SB(1, 1), cB + hstepB + kstep, voffB);
        PG8_WAIT_V(6); PG8_BAR;
    }
    for (;;) {
        const bool has_next = S.next(ui + 1, nxt);
        const char* nA = has_next ? (const char*)g.A + (size_t)nxt.pm * tstepA + nxt.aoff : cA; const char* nB = has_next ? (const char*)g.Bt + (size_t)nxt.pn * tstepB + nxt.boff : cB;
        for (int t = 0; t < nt; t += 2) {
            const bool last = (t == nt - 2);
            const char* a1 = cA + (size_t)(t + 1) * kstep;
            const char* a2 = last ? nA : cA + (size_t)(t + 2) * kstep; const char* b2 = last ? nB : cB + (size_t)(t + 2) * kstep;
            const char* a3 = a2 + kstep; const char* b3 = b2 + kstep;
            if constexpr (SP2) {
            PG8_LDB(B0, 0, 0); PG8_LDB(B1, 0, 1); PG8_SCHED; PG8_LDA(At, 0, 0); PG8_STAGE(PG8_SA(1, 1), a1 + hstepA, voffA);
            PG8_WAIT_V(8); PG8_WAIT_L(0); PG8_BAR; PG8_MMA(0, 0, At, B0); PG8_MMA(0, 1, At, B1); PG8_BAR; PG8_SCHED;
            PG8_LDA(At, 0, 1); PG8_STAGE(PG8_SB(0, 0), b2, voffB); PG8_STAGE(PG8_SB(0, 1), b2 + hstepB, voffB); PG8_STAGE(PG8_SA(0, 0), a2, voffA);
            PG8_WAIT_V(8); PG8_WAIT_L(0); PG8_BAR; PG8_MMA(1, 0, At, B0); PG8_MMA(1, 1, At, B1); PG8_BAR; PG8_SCHED;
            PG8_LDB(B0, 1, 0); PG8_LDB(B1, 1, 1); PG8_SCHED; PG8_LDA(At, 1, 0); PG8_STAGE(PG8_SA(0, 1), a2 + hstepA, voffA);
            PG8_WAIT_V(8); PG8_WAIT_L(0); PG8_BAR; PG8_MMA(0, 0, At, B0); PG8_MMA(0, 1, At, B1); PG8_BAR; PG8_SCHED;
            PG8_LDA(At, 1, 1); PG8_STAGE(PG8_SB(1, 0), b3, voffB); PG8_STAGE(PG8_SB(1, 1), b3 + hstepB, voffB); PG8_STAGE(PG8_SA(1, 0), a3, voffA);
            PG8_WAIT_V(8); PG8_WAIT_L(0); PG8_BAR; PG8_MMA(1, 0, At, B0); PG8_MMA(1, 1, At, B1); PG8_BAR; PG8_SCHED;
            } else {
            PG8_LDB(B0, 0, 0); PG8_SCHED; PG8_LDA(At, 0, 0); PG8_STAGE(PG8_SA(1, 1), a1 + hstepA, voffA);
            PG8_WAIT_L(8); PG8_BAR; PG8_WAIT_L(0); PG8_MMA(0, 0, At, B0); PG8_BAR; PG8_SCHED;
            PG8_LDB(B1, 0, 1); PG8_STAGE(PG8_SB(0, 0), b2, voffB);
            PG8_BAR; PG8_WAIT_L(0); PG8_MMA(0, 1, At, B1); PG8_BAR;
            PG8_LDA(At, 0, 1); PG8_STAGE(PG8_SA(0, 0), a2, voffA);
            PG8_BAR; PG8_WAIT_L(0); PG8_MMA(1, 0, At, B0); PG8_BAR; PG8_SCHED;
            PG8_STAGE(PG8_SB(0, 1), b2 + hstepB, voffB);
            PG8_WAIT_V(6); PG8_BAR; PG8_MMA(1, 1, At, B1); PG8_BAR;
            PG8_LDB(B0, 1, 0); PG8_SCHED; PG8_LDA(At, 1, 0); PG8_STAGE(PG8_SA(0, 1), a2 + hstepA, voffA);
            PG8_WAIT_L(8); PG8_BAR; PG8_WAIT_L(0); PG8_MMA(0, 0, At, B0); PG8_BAR; PG8_SCHED;
            PG8_LDB(B1, 1, 1); PG8_STAGE(PG8_SB(1, 0), b3, voffB);
            PG8_BAR; PG8_WAIT_L(0); PG8_MMA(0, 1, At, B1); PG8_BAR;
            PG8_LDA(At, 1, 1); PG8_STAGE(PG8_SA(1, 0), a3, voffA);
            PG8_BAR; PG8_WAIT_L(0); PG8_MMA(1, 0, At, B0); PG8_BAR; PG8_SCHED;
            PG8_STAGE(PG8_SB(1, 1), b3 + hstepB, voffB);
            PG8_WAIT_V(6); PG8_BAR; PG8_MMA(1, 1, At, B1); PG8_BAR;
            }
        }
        if constexpr (ALIGN_EPI) { if (wr == 0) PG8_BAR; }
        E(acc, cur, wr, wc, fr, fq);
        if (!has_next) break;
        if (cur.part != 1) {
#pragma unroll
        for (int a = 0; a < 2; ++a)
#pragma unroll
            for (int b = 0; b < 2; ++b)
#pragma unroll
                for (int m = 0; m < 4; ++m)
#pragma unroll
                    for (int n = 0; n < 2; ++n) acc[a][b][m][n] = (f32x4){0.f, 0.f, 0.f, 0.f};
        }
        cur = nxt; cA = nA; cB = nB; ++ui;
        if constexpr (ALIGN_EPI) { if (wr == 1) PG8_BAR; }
    }
    PG8_WAIT_V(0);
    if constexpr (!ALIGN_EPI) { if (wr == 0) PG8_BAR; }
    PG8_BAR;
#undef PG8_SA
#undef PG8_SB
#undef PG8_STAGE
#undef PG8_LDA
#undef PG8_LDB
#undef PG8_MMA
#undef PG8_WAIT_V
#undef PG8_WAIT_L
#undef PG8_BAR
#undef PG8_SCHED
}

__device__ __forceinline__ float gelu_tanh(float x) {
    const float t = 1.5957691216f * (x + 0.044715f * x * x * x);
    return x * __builtin_amdgcn_rcpf(1.0f + __expf(-t));
}
__device__ __forceinline__ float sigmoid_c(float x) { const float s = __builtin_amdgcn_rcpf(1.0f + __expf(-x)); return s < 1e-30f ? 1e-30f : s; }

struct EpiIn {
    static constexpr bool PERM = true;
    const float* rstd0; bf16_t* Z; bf16_t* Q; bf16_t* Kb; bf16_t* G; const float* bgate; const float2* rope;
    __device__ __forceinline__ void operator()(f32x4 (&acc)[2][2][4][2], const Unit& u, int wr, int wc, int fr, int fq) const {
        const int cb = u.pn * BM;
        const int row0 = u.pm * BM + wr * 64 + fr;
        const int cl = wc * 32 + fq * 8;
        float rsv[8];
#pragma unroll
        for (int i = 0; i < 8; ++i) rsv[i] = rstd0[row0 + (i >> 2) * HALF + (i & 3) * 16];
        if (cb < 1024) {
#pragma unroll
            for (int i = 0; i < 8; ++i) { const int ai = i >> 2, m = i & 3; const int row = row0 + ai * HALF + m * 16; const float rs = rsv[i]; bf16_t* rp = Z + (size_t)row * 1024 + cb + cl;
#pragma unroll
                for (int bj = 0; bj < 2; ++bj) { const f32x4 v0 = acc[ai][bj][m][0] * rs, v1 = acc[ai][bj][m][1] * rs; u32x4 w;
                    w.x = cvt_pk_bf16(gelu_tanh(v0[0]), gelu_tanh(v0[1])); w.y = cvt_pk_bf16(gelu_tanh(v0[2]), gelu_tanh(v0[3]));
                    w.z = cvt_pk_bf16(gelu_tanh(v1[0]), gelu_tanh(v1[1])); w.w = cvt_pk_bf16(gelu_tanh(v1[2]), gelu_tanh(v1[3]));
                    *(u32x4*)(rp + bj * HALF) = w; }
                asm volatile("" ::: "memory"); }
        } else if (cb < 4096) {
            const bool isq = cb < 2560; bf16_t* base = isq ? Q : Kb; const int c0 = cb - (isq ? 1024 : 2560);
            const float sc = isq ? 0.12751741f : 1.0f;
            const int hd0 = c0 >> 7, shift = 2 * (hd0 >> 2);
            const float sgn = (fq < 2) ? -1.0f : 1.0f;
            f32x4 cs[4], csn[4];
            if (wc == 0) { const f32x4* rpp = (const f32x4*)(rope + (size_t)(row0 & (SEQ - 1)) * 16 + (fq & 1) * 8); cs[0] = rpp[0]; cs[1] = rpp[1]; cs[2] = rpp[2]; cs[3] = rpp[3]; }
#pragma unroll
            for (int i = 0; i < 8; ++i) { const int ai = i >> 2, m = i & 3; const int row = row0 + ai * HALF + m * 16; const float rs = rsv[i] * sc;
                if (wc == 0 && i < 7) { const int rown = row0 + ((i + 1) >> 2) * HALF + ((i + 1) & 3) * 16;
                    const f32x4* rpp = (const f32x4*)(rope + (size_t)(rown & (SEQ - 1)) * 16 + (fq & 1) * 8); csn[0] = rpp[0]; csn[1] = rpp[1]; csn[2] = rpp[2]; csn[3] = rpp[3]; }
                const int bb = row >> 11, sq = row & (SEQ - 1), uu = ((sq & ((1 << shift) - 1)) << (11 - shift)) + (sq >> shift);
                bf16_t* rp = base + ((size_t)(bb * 12 + hd0) * SEQ + uu) * 128 + cl;
#pragma unroll
                for (int bj = 0; bj < 2; ++bj) { f32x4 v0 = acc[ai][bj][m][0] * rs, v1 = acc[ai][bj][m][1] * rs;
                    if (wc == 0) { f32x4 p0, p1;
#pragma unroll
                        for (int j = 0; j < 4; ++j) { p0[j] = __shfl_xor(v0[j], 32); p1[j] = __shfl_xor(v1[j], 32); }
                        v0[0] = v0[0] * cs[0][0] + sgn * p0[0] * cs[0][1]; v0[1] = v0[1] * cs[0][2] + sgn * p0[1] * cs[0][3];
                        v0[2] = v0[2] * cs[1][0] + sgn * p0[2] * cs[1][1]; v0[3] = v0[3] * cs[1][2] + sgn * p0[3] * cs[1][3];
                        v1[0] = v1[0] * cs[2][0] + sgn * p1[0] * cs[2][1]; v1[1] = v1[1] * cs[2][2] + sgn * p1[1] * cs[2][3];
                        v1[2] = v1[2] * cs[3][0] + sgn * p1[2] * cs[3][1]; v1[3] = v1[3] * cs[3][2] + sgn * p1[3] * cs[3][3]; }
                    u32x4 w; w.x = cvt_pk_bf16(v0[0], v0[1]); w.y = cvt_pk_bf16(v0[2], v0[3]); w.z = cvt_pk_bf16(v1[0], v1[1]); w.w = cvt_pk_bf16(v1[2], v1[3]);
                    *(u32x4*)(rp + (size_t)bj * SEQ * 128) = w; }
                if (wc == 0 && i < 7) { cs[0] = csn[0]; cs[1] = csn[1]; cs[2] = csn[2]; cs[3] = csn[3]; }
                asm volatile("" ::: "memory"); }
        } else {
            const int c0 = cb - 5632;
            f32x4 bg[2][2];
#pragma unroll
            for (int bj = 0; bj < 2; ++bj) { bg[bj][0] = *(const f32x4*)(bgate + c0 + cl + bj * HALF); bg[bj][1] = *(const f32x4*)(bgate + c0 + cl + bj * HALF + 4); }
#pragma unroll
            for (int i = 0; i < 8; ++i) { const int ai = i >> 2, m = i & 3; const int row = row0 + ai * HALF + m * 16; const float rs = rsv[i]; bf16_t* rp = G + (size_t)row * 2048 + c0 + cl;
#pragma unroll
                for (int bj = 0; bj < 2; ++bj) { const f32x4 v0 = acc[ai][bj][m][0] * rs + bg[bj][0], v1 = acc[ai][bj][m][1] * rs + bg[bj][1]; u32x4 w;
                    w.x = cvt_pk_bf16(sigmoid_c(v0[0]), sigmoid_c(v0[1])); w.y = cvt_pk_bf16(sigmoid_c(v0[2]), sigmoid_c(v0[3]));
                    w.z = cvt_pk_bf16(sigmoid_c(v1[0]), sigmoid_c(v1[1])); w.w = cvt_pk_bf16(sigmoid_c(v1[2]), sigmoid_c(v1[3]));
                    *(u32x4*)(rp + bj * HALF) = w; }
                asm volatile("" ::: "memory"); }
        }
    }
};
struct EpiVT {
    static constexpr bool PERM = true;
    const float* rstdu; bf16_t* VT; int g;
    __device__ __forceinline__ void operator()(f32x4 (&acc)[2][2][4][2], const Unit& u, int wr, int wc, int fr, int fq) const {
        const int b = u.pn >> 3, t8 = u.pn & 7;
        const int r0 = (u.pm & 1) * BM + wr * 64 + fr;
        f32x4 rs[2][2];
#pragma unroll
        for (int bj = 0; bj < 2; ++bj) { const float* rp = rstdu + (size_t)g * M + (size_t)u.pn * BM + bj * HALF + wc * 32 + fq * 8; rs[bj][0] = *(const f32x4*)rp; rs[bj][1] = *(const f32x4*)(rp + 4); }
#pragma unroll
        for (int ai = 0; ai < 2; ++ai)
#pragma unroll
            for (int m = 0; m < 4; ++m) { const int r = r0 + ai * HALF + m * 16; const int hd = 4 * g + (r >> 7), dimh = r & 127;
#pragma unroll
                for (int bj = 0; bj < 2; ++bj) { const int kt = t8 * 8 + bj * 4 + wc;
                    const f32x4 v0 = acc[ai][bj][m][0] * rs[bj][0], v1 = acc[ai][bj][m][1] * rs[bj][1];
                    u32x4 w; w.x = cvt_pk_bf16(v0[0], v0[1]); w.y = cvt_pk_bf16(v0[2], v0[3]); w.z = cvt_pk_bf16(v1[0], v1[1]); w.w = cvt_pk_bf16(v1[2], v1[3]);
                    *(u32x4*)(VT + ((size_t)((b * 12 + hd) * 64 + kt) * 128 + dimh) * 32 + fq * 8) = w; } }
    }
};

struct EpiMerge {
    static constexpr bool PERM = true;
    const bf16_t* G; bf16_t* O;
    __device__ __forceinline__ void operator()(f32x4 (&acc)[2][2][4][2], const Unit& u, int wr, int wc, int fr, int fq) const {
        const int row0 = u.pm * BM + wr * 64 + fr, col0 = u.pn * BM + wc * 32 + 8 * fq;
        const bool first = (u.part == 1);
        u32x4 ga[2], gb[2], gan[2], gbn[2];
        { const bf16_t* gp = G + (size_t)row0 * 2048 + col0;
#pragma unroll
          for (int bj = 0; bj < 2; ++bj) { gb[bj] = *(const u32x4*)(gp + 1024 + bj * HALF); if (first) ga[bj] = *(const u32x4*)(gp + bj * HALF); } }
#pragma unroll
        for (int i = 0; i < 8; ++i) { const int ai = i >> 2, m = i & 3; const int row = row0 + ai * HALF + m * 16;
            if (i < 7) { const bf16_t* gp = G + (size_t)(row0 + ((i + 1) >> 2) * HALF + ((i + 1) & 3) * 16) * 2048 + col0;
#pragma unroll
                for (int bj = 0; bj < 2; ++bj) { gbn[bj] = *(const u32x4*)(gp + 1024 + bj * HALF); if (first) gan[bj] = *(const u32x4*)(gp + bj * HALF); } }
#pragma unroll
            for (int bj = 0; bj < 2; ++bj) {
                f32x4 b0 = {bf_lo(gb[bj].x), bf_hi(gb[bj].x), bf_lo(gb[bj].y), bf_hi(gb[bj].y)}, b1 = {bf_lo(gb[bj].z), bf_hi(gb[bj].z), bf_lo(gb[bj].w), bf_hi(gb[bj].w)};
                if (first) {
                    f32x4 a0 = {bf_lo(ga[bj].x), bf_hi(ga[bj].x), bf_lo(ga[bj].y), bf_hi(ga[bj].y)}, a1 = {bf_lo(ga[bj].z), bf_hi(ga[bj].z), bf_lo(ga[bj].w), bf_hi(ga[bj].w)};
                    f32x4 r0, r1;
#pragma unroll
                    for (int j = 0; j < 4; ++j) { r0[j] = a0[j] * __builtin_amdgcn_rcpf(b0[j]); r1[j] = a1[j] * __builtin_amdgcn_rcpf(b1[j]); }
                    acc[ai][bj][m][0] = acc[ai][bj][m][0] * r0; acc[ai][bj][m][1] = acc[ai][bj][m][1] * r1;
                } else { const f32x4 v0 = acc[ai][bj][m][0] * b0, v1 = acc[ai][bj][m][1] * b1;
                    u32x4 w; w.x = cvt_pk_bf16(v0[0], v0[1]); w.y = cvt_pk_bf16(v0[2], v0[3]); w.z = cvt_pk_bf16(v1[0], v1[1]); w.w = cvt_pk_bf16(v1[2], v1[3]);
                    *(u32x4*)(O + (size_t)row * 1024 + col0 + bj * HALF) = w; } }
            if (i < 7) { gb[0] = gbn[0]; gb[1] = gbn[1]; if (first) { ga[0] = gan[0]; ga[1] = gan[1]; } }
            asm volatile("" ::: "memory"); }
    }
};

template <int ACT, bool SS> struct EpiStore {
    static constexpr bool PERM = true;
    bf16_t* O; int ldc; float* ss;
    __device__ __forceinline__ void operator()(f32x4 (&acc)[2][2][4][2], const Unit& u, int wr, int wc, int fr, int fq) const {
        const int row0 = u.pm * BM + wr * 64 + fr, col0 = u.pn * BM + wc * 32 + 8 * fq;
#pragma unroll
        for (int ai = 0; ai < 2; ++ai)
#pragma unroll
            for (int m = 0; m < 4; ++m) { const int row = row0 + ai * HALF + m * 16; bf16_t* rp = O + (size_t)row * ldc + col0; float s = 0.f;
#pragma unroll
                for (int bj = 0; bj < 2; ++bj) { f32x4 v0 = acc[ai][bj][m][0], v1 = acc[ai][bj][m][1];
                    if (ACT == 1) {
#pragma unroll
                        for (int j = 0; j < 4; ++j) { const float a = fmaxf(v0[j], 0.f), b = fmaxf(v1[j], 0.f); v0[j] = a * a; v1[j] = b * b; } }
                    if (SS) s += (v0[0] * v0[0] + v0[1] * v0[1]) + (v0[2] * v0[2] + v0[3] * v0[3]) + (v1[0] * v1[0] + v1[1] * v1[1]) + (v1[2] * v1[2] + v1[3] * v1[3]);
                    u32x4 w; w.x = cvt_pk_bf16(v0[0], v0[1]); w.y = cvt_pk_bf16(v0[2], v0[3]); w.z = cvt_pk_bf16(v1[0], v1[1]); w.w = cvt_pk_bf16(v1[2], v1[3]);
                    *(u32x4*)(rp + bj * HALF) = w; }
                if (SS) { s += __shfl_xor(s, 16); s += __shfl_xor(s, 32); if (fq == 0) atomicAdd(ss + row, s); } }
    }
};
}

struct Params { const float* in[16]; float* out; unsigned char* ws; };
typedef const Params __attribute__((address_space(4))) CParams;
__device__ __forceinline__ Params load_params() {
    CParams* pp = (CParams*)__builtin_amdgcn_kernarg_segment_ptr();
    asm volatile("" : "+s"(pp));
    Params q;
#pragma unroll
    for (int i = 0; i < 16; ++i) q.in[i] = pp->in[i];
    q.out = pp->out; q.ws = pp->ws; return q;
}

__device__ __forceinline__ void p0_transpose_item(const float* W, int K, int N, bf16_t* WT, int ldk, const float* gain, LAS float* scr, int item, int lane) {
    const int nblk = N / 32, kb = item / nblk, nb = item % nblk, k0 = 64 * kb, n0 = 32 * nb;
    float wv[32];
#pragma unroll
    for (int i = 0; i < 32; ++i) wv[i] = W[(size_t)(k0 + 2 * i + (lane >> 5)) * N + n0 + (lane & 31)];
    if (gain) {
#pragma unroll
        for (int i = 0; i < 32; ++i) wv[i] *= gain[k0 + 2 * i + (lane >> 5)];
    }
#pragma unroll
    for (int i = 0; i < 32; ++i) scr[(2 * i + (lane >> 5)) * 33 + (lane & 31)] = wv[i];
    asm volatile("s_waitcnt lgkmcnt(0)" ::: "memory");
    const int c = lane & 7;
#pragma unroll
    for (int j = 0; j < 4; ++j) { const int n = (lane >> 3) + 8 * j; const LAS float* s = scr + (8 * c) * 33 + n;
        u32x4 o; o.x = cvt_pk_bf16(s[0 * 33], s[1 * 33]); o.y = cvt_pk_bf16(s[2 * 33], s[3 * 33]); o.z = cvt_pk_bf16(s[4 * 33], s[5 * 33]); o.w = cvt_pk_bf16(s[6 * 33], s[7 * 33]);
        *(u32x4*)(WT + (size_t)(n0 + n) * ldk + k0 + 8 * c) = o; }
    asm volatile("s_waitcnt lgkmcnt(0)" ::: "memory");
}

__device__ __forceinline__ void sincos_acc(float a, float& c, float& s) {
    const double x = (double)a;
    const double q = __builtin_rint(x * 0.63661977236758134308);
    const double r = (x - q * 1.5707963267948966192) - q * 6.123233995736766e-17;
    const double r2 = r * r;
    double sp = 1.0 / 6227020800.0; sp = sp * r2 * (-1.0) + 1.0 / 39916800.0; sp = -sp * r2 + 1.0 / 362880.0; sp = -sp * r2 + 1.0 / 5040.0; sp = -sp * r2 + 1.0 / 120.0; sp = -sp * r2 + 1.0 / 6.0; sp = -sp * r2 + 1.0;
    const double sn = sp * r;
    double cp = 1.0 / 87178291200.0; cp = -cp * r2 + 1.0 / 479001600.0; cp = -cp * r2 + 1.0 / 3628800.0; cp = -cp * r2 + 1.0 / 40320.0; cp = -cp * r2 + 1.0 / 720.0; cp = -cp * r2 + 1.0 / 24.0; cp = -cp * r2 + 0.5; cp = -cp * r2 + 1.0;
    const int qi = ((int)q) & 3;
    double cc = (qi & 1) ? sn : cp, ss = (qi & 1) ? cp : sn;
    if (qi == 1 || qi == 2) cc = -cc;
    if (qi >= 2) ss = -ss;
    c = (float)cc; s = (float)ss;
}

__constant__ float c_inv_freq[16] = {
    1.0f, 0.440366596f, 0.193922743f, 0.0853971019f, 0.0376060307f, 0.0165604409f, 0.00729266461f, 0.00321144611f,
    0.00141421356f, 0.000622772437f, 0.000274248188f, 0.000120769735f, 5.31829573e-05f, 2.34199997e-05f, 1.03133852e-05f, 4.54167048e-06f};

__device__ __forceinline__ void phase_prep(const Params& p, LAS unsigned char* lds, int G, int bid) {
    const int tid = tid_fresh(), lane = tid & 63, wave = __builtin_amdgcn_readfirstlane(tid >> 6);
    unsigned char* ws = p.ws; unsigned char* dob = (unsigned char*)p.out;
    const int gw = bid * 8 + wave, NGW = G * 8;
    LAS float* scr = (LAS float*)(lds + wave * 16384);
    constexpr int I_IN = 16 * 240, I_A = 8 * 32, I_B = 8 * 32, I_O = 16 * 32, I_U = 16 * 128, I_D = 64 * 32;
    constexpr int NITEMS = I_IN + I_A + I_B + I_O + I_U + I_D;
    for (int it = gw; it < NITEMS; it += NGW) {
        int r = it;
        if (r < I_IN) { p0_transpose_item(p.in[2], 1024, DIN, (bf16_t*)(dob + DO_WIN), 1024, p.in[1], scr, r, lane); continue; } r -= I_IN;
        if (r < I_A) { p0_transpose_item(p.in[8], 512, 1024, (bf16_t*)(ws + WS_WAB), 512, nullptr, scr, r, lane); continue; } r -= I_A;
        if (r < I_B) { p0_transpose_item(p.in[9], 512, 1024, (bf16_t*)(ws + WS_WAB) + 1024 * 512, 512, nullptr, scr, r, lane); continue; } r -= I_B;
        if (r < I_O) { p0_transpose_item(p.in[10], 1024, 1024, (bf16_t*)(ws + WS_WOUT), 1024, nullptr, scr, r, lane); continue; } r -= I_O;
        if (r < I_U) { p0_transpose_item(p.in[13], 1024, FF, (bf16_t*)(ws + WS_WUP), 1024, p.in[12], scr, r, lane); continue; } r -= I_U;
        p0_transpose_item(p.in[14], FF, 1024, (bf16_t*)(ws + WS_WDOWN), FF, nullptr, scr, r, lane);
    }
    const float* x = p.in[0]; bf16_t* xb = (bf16_t*)(dob + DO_XB); float* rstd0 = (float*)(ws + WS_RSTD0);
    for (int m0 = gw; m0 < M; m0 += 4 * NGW) {
        f32x4 v[4][4];
#pragma unroll
        for (int i = 0; i < 4; ++i) { const int mm = (m0 + i * NGW < M) ? m0 + i * NGW : M - 1; const f32x4* xr = (const f32x4*)(x + (size_t)mm * D) + lane;
#pragma unroll
            for (int j = 0; j < 4; ++j) v[i][j] = __builtin_nontemporal_load(xr + 64 * j); }
#pragma unroll
        for (int i = 0; i < 4; ++i) { const int m = (m0 + i * NGW < M) ? m0 + i * NGW : M - 1; float s = 0.f;
#pragma unroll
            for (int j = 0; j < 4; ++j) s += (v[i][j][0] * v[i][j][0] + v[i][j][1] * v[i][j][1]) + (v[i][j][2] * v[i][j][2] + v[i][j][3] * v[i][j][3]);
            s = wave_sum(s);
            u32x2* o8 = (u32x2*)(xb + (size_t)m * D) + lane;
#pragma unroll
            for (int j = 0; j < 4; ++j) { u32x2 w; w.x = cvt_pk_bf16(v[i][j][0], v[i][j][1]); w.y = cvt_pk_bf16(v[i][j][2], v[i][j][3]); o8[64 * j] = w; }
            if (lane == 0) { const float rv = 1.0f / sqrtf(s * (1.0f / D) + EPS); rstd0[m] = rv; float* ru = (float*)(ws + WS_RSTDU);
                const int bb = m & ~(SEQ - 1), sq = m & (SEQ - 1);
                ru[m] = rv; ru[M + bb + ((sq & 3) << 9) + (sq >> 2)] = rv; ru[2 * M + bb + ((sq & 15) << 7) + (sq >> 4)] = rv; } }
    }
    const int gt = bid * 512 + tid, NGT = G * 512;
    { const float* wsp = p.in[6]; bf16_t* o = (bf16_t*)(ws + WS_WSP);
      for (int i = gt; i < 4 * 128 * 128 / 2; i += NGT) ((unsigned*)o)[i] = cvt_pk_bf16(wsp[2 * i], wsp[2 * i + 1]); }
    { float2* rope = (float2*)(ws + WS_ROPE);
      for (int i = gt; i < SEQ * 16; i += NGT) { const float ang = (float)(i >> 4) * c_inv_freq[i & 15]; float c, s; sincos_acc(ang, c, s); rope[i] = make_float2(c, s); } }
    { float* z = (float*)(ws + WS_SS1); for (int i = gt; i < 2 * M; i += NGT) z[i] = 0.f; }
}

__device__ __forceinline__ void gmlp_unit(const Params& p, LAS unsigned char* lds, int chunk) {
    const int tid = tid_fresh(), lane = tid & 63, wave = __builtin_amdgcn_readfirstlane(tid >> 6);
    bf16_t* Z = (bf16_t*)(p.ws + WS_Z);
    const bf16_t* WSP = (const bf16_t*)(p.ws + WS_WSP);
    const float* lng = p.in[4]; const float* lnb = p.in[5]; const float* bsp = p.in[7];
    LAS f32x2* part = (LAS f32x2*)(lds + 512 * VT_PITCH);
    const int s = tid & 127, cq = tid >> 7;
    const bf16_t* vrow = Z + (size_t)(chunk * 128 + s) * 1024 + 512 + cq * 128;
    {   float sm = 0.f, sq = 0.f;
#pragma unroll 4
        for (int j = 0; j < 16; ++j) { const u32x4 w = *(const u32x4*)(vrow + 8 * j);
            const float a0 = bf_lo(w.x), a1 = bf_hi(w.x), a2 = bf_lo(w.y), a3 = bf_hi(w.y), a4 = bf_lo(w.z), a5 = bf_hi(w.z), a6 = bf_lo(w.w), a7 = bf_hi(w.w);
            sm += ((a0 + a1) + (a2 + a3)) + ((a4 + a5) + (a6 + a7));
            sq += ((a0 * a0 + a1 * a1) + (a2 * a2 + a3 * a3)) + ((a4 * a4 + a5 * a5) + (a6 * a6 + a7 * a7)); }
        part[cq * 128 + s] = (f32x2){sm, sq};
    }
    __syncthreads();
    float mu, rstd;
    {   const f32x2 a = part[s], b = part[128 + s], c = part[256 + s], d = part[384 + s];
        const float sm = (a.x + b.x) + (c.x + d.x), sq = (a.y + b.y) + (c.y + d.y);
        mu = sm * (1.0f / 512.0f); const float var = fmaxf(sq * (1.0f / 512.0f) - mu * mu, 0.f); rstd = 1.0f / sqrtf(var + EPS); }
    {   LAS bf16_t* vt = (LAS bf16_t*)lds;
#pragma unroll 2
        for (int j = 0; j < 16; ++j) { const u32x4 w = *(const u32x4*)(vrow + 8 * j); const int c0 = cq * 128 + 8 * j;
            const float a[8] = {bf_lo(w.x), bf_hi(w.x), bf_lo(w.y), bf_hi(w.y), bf_lo(w.z), bf_hi(w.z), bf_lo(w.w), bf_hi(w.w)};
#pragma unroll
            for (int e = 0; e < 8; e += 2) { const float y0 = (a[e] - mu) * rstd * lng[c0 + e] + lnb[c0 + e], y1 = (a[e + 1] - mu) * rstd * lng[c0 + e + 1] + lnb[c0 + e + 1];
                const unsigned pk = cvt_pk_bf16(y0, y1);
                vt[(c0 + e) * (VT_PITCH / 2) + s] = (bf16_t)(pk & 0xffffu); vt[(c0 + e + 1) * (VT_PITCH / 2) + s] = (bf16_t)(pk >> 16); } }
    }
    __syncthreads();
    const int g = wave >> 1, fr = lane & 15, fq = lane >> 4;
    f32x4 acc[4][8];
#pragma unroll
    for (int ct = 0; ct < 4; ++ct)
#pragma unroll
        for (int tt = 0; tt < 8; ++tt) acc[ct][tt] = (f32x4){0.f, 0.f, 0.f, 0.f};
    const bf16_t* wg = WSP + (size_t)g * 128 * 128 + fr * 128 + fq * 8;
    const LAS unsigned char* va = lds + (wave * 64 + fr) * VT_PITCH + fq * 16;
#pragma unroll 1
    for (int ks = 0; ks < 4; ++ks) {
        bf16x8 af[4], bfr[8];
#pragma unroll
        for (int tt = 0; tt < 8; ++tt) bfr[tt] = *(const bf16x8*)(wg + tt * 16 * 128 + ks * 32);
#pragma unroll
        for (int ct = 0; ct < 4; ++ct) af[ct] = *(const LAS bf16x8*)(va + ct * 16 * VT_PITCH + ks * 64);
#pragma unroll
        for (int ct = 0; ct < 4; ++ct)
#pragma unroll
            for (int tt = 0; tt < 8; ++tt) acc[ct][tt] = __builtin_amdgcn_mfma_f32_16x16x32_bf16(af[ct], bfr[tt], acc[ct][tt], 0, 0, 0);
    }
#pragma unroll
    for (int tt = 0; tt < 8; ++tt) { const int t = 16 * tt + fr; const float bs = bsp[g * 128 + t]; bf16_t* zr = Z + (size_t)(chunk * 128 + t) * 1024 + wave * 64 + 4 * fq;
#pragma unroll
        for (int ct = 0; ct < 4; ++ct) { const u32x2 uw = *(const u32x2*)(zr + 16 * ct); const f32x4 a = acc[ct][tt];
            u32x2 o; o.x = cvt_pk_bf16(bf_lo(uw.x) * (a[0] + bs), bf_hi(uw.x) * (a[1] + bs)); o.y = cvt_pk_bf16(bf_lo(uw.y) * (a[2] + bs), bf_hi(uw.y) * (a[3] + bs));
            *(u32x2*)(zr + 16 * ct) = o; } }
    __syncthreads();
}

struct AttnPend { bf16_t* pog; float* plse; float lsev; };
__device__ __forceinline__ void attn_flush(const AttnPend& pd, const LAS unsigned char* ob, int lane, int i0, int i1) {
#pragma unroll
    for (int i = 0; i < 8; ++i) if (i >= i0 && i < i1) { const int row = i * 4 + (lane >> 4), ch = lane & 15;
        const u32x4 w = *(const LAS u32x4*)(ob + row * 272 + ch * 16);
        *(u32x4*)(pd.pog + row * 128 + ch * 8) = w; }
}
__device__ __forceinline__ void attn_block_unit(const Params& p, LAS unsigned char* lds, int bu, AttnPend& pd, int wave, int lane) {
    const bf16_t* Q = (const bf16_t*)(p.ws + WS_Q); const bf16_t* Kb = (const bf16_t*)(p.ws + WS_K); const bf16_t* VT = (const bf16_t*)(p.ws + WS_VT);
    bf16_t* OG = (bf16_t*)((unsigned char*)p.out + DO_OG); float* LSE = (float*)((unsigned char*)p.out + DO_LSE);
    const int bh = bu >> 3, qt0 = (bu & 7) * 8, hd = bh % 12, b = bh / 12;
    const int g = hd >> 2, lb = 11 - 2 * g, rsh = lb - 5;
    const int qt = qt0 + wave, up0 = qt * 32, myres = qt >> rsh;
    const int ql = lane & 31, h = lane >> 5;
    const int qls = (ql & 19) | ((ql & 4) << 1) | ((ql & 8) >> 1);
    const unsigned okx = (unsigned)(lane >> 4) * 256u + ((((unsigned)((lane & 15) ^ (lane >> 4))) ^ (4u * (unsigned)(wave & 3))) << 4) + (unsigned)wave * 1024u;
    const unsigned ovx = (unsigned)(lane >> 2) * 64u + (unsigned)(((lane & 3) ^ ((lane >> 4) & 3)) << 4) + (unsigned)wave * 1024u;
    const char* kbase = (const char*)(Kb + (size_t)bh * SEQ * 128); const char* vbase = (const char*)(VT + (size_t)bh * SEQ * 128);
#define ATT_DMA(bufo, kt_) do { const size_t _to = (size_t)(kt_) * 8192; \
        __builtin_amdgcn_global_load_lds((const unsigned*)(kbase + _to + okx), (LAS unsigned*)(lds + (bufo) + wave * 1024), 16, 0, 0); \
        __builtin_amdgcn_global_load_lds((const unsigned*)(vbase + _to + ovx), (LAS unsigned*)(lds + (bufo) + 8192 + wave * 1024), 16, 0, 0); } while (0)
    const int k0 = (qt0 >= 2) ? qt0 - 2 : 0, k1 = (qt0 + 9 <= 63) ? qt0 + 9 : 63;
    ATT_DMA(0, k0);
    bf16x8 qf[8];
    { const bf16_t* qp = Q + ((size_t)bh * SEQ + up0 + ql) * 128 + 8 * h;
#pragma unroll
      for (int ks = 0; ks < 8; ++ks) qf[ks] = *(const bf16x8*)(qp + 16 * ks); }
    f32x16 o[4];
#pragma unroll
    for (int dt = 0; dt < 4; ++dt)
#pragma unroll
        for (int e = 0; e < 16; ++e) o[dt][e] = 0.f;
    float mrun = -1e30f, lrun = 0.f;
    const int kx = qls & 15, vx = (ql >> 2) & 3;
#pragma unroll 1
    for (int kt = k0; kt <= k1; ++kt) {
        const int bo = ((kt - k0) & 1) * 16384;
        asm volatile("s_waitcnt vmcnt(0)" ::: "memory");
        __syncthreads();
        if (kt < k1) ATT_DMA(16384 - bo, kt + 1);
        if (pd.pog != nullptr && kt - k0 < 4) {
            const LAS unsigned char* ob = lds + 32768 + wave * (32 * 272); const int sidx = kt - k0;
            attn_flush(pd, ob, lane, 2 * sidx, 2 * sidx + 2);
            if (sidx == 0 && (lane >> 5) == 0) pd.plse[lane & 31] = pd.lsev;
        }
        const int t = kt - qt + 2;
        if (t < 0 || t > 4 || (kt >> rsh) != myres) continue;
        const LAS unsigned char* kl = lds + bo + qls * 256;
        const LAS unsigned char* vl = lds + bo + 8192 + ql * 64;
        bf16x8 kf[8], vf[4][2];
#pragma unroll
        for (int ks = 0; ks < 8; ++ks) kf[ks] = *(const LAS bf16x8*)(kl + (((2 * ks + h) ^ kx) << 4));
#pragma unroll
        for (int dt = 0; dt < 4; ++dt)
#pragma unroll
            for (int s2 = 0; s2 < 2; ++s2) vf[dt][s2] = *(const LAS bf16x8*)(vl + dt * 2048 + (((2 * s2 + h) ^ vx) << 4));
        f32x16 x;
#pragma unroll
        for (int e = 0; e < 16; ++e) x[e] = 0.f;
#pragma unroll
        for (int ks = 0; ks < 8; ++ks) x = __builtin_amdgcn_mfma_f32_32x32x16_bf16(kf[ks], qf[ks], x, 0, 0, 0);
        if (t == 0) {
#pragma unroll
            for (int e = 0; e < 16; ++e) { const int kr = 16 * (e >> 3) + 8 * h + (e & 7); if (kr < ql) x[e] = -1e30f; }
        }
        if (t == 4) {
#pragma unroll
            for (int e = 0; e < 16; ++e) { const int kr = 16 * (e >> 3) + 8 * h + (e & 7); if (kr > ql) x[e] = -1e30f; }
        }
        float mx = x[0];
#pragma unroll
        for (int e = 1; e < 16; ++e) mx = fmaxf(mx, x[e]);
        mx = fmaxf(mx, __shfl_xor(mx, 32));
        const float mnew = fmaxf(mrun, mx); const float alpha = __builtin_amdgcn_exp2f(mrun - mnew); mrun = mnew;
        float ps = 0.f;
#pragma unroll
        for (int e = 0; e < 16; ++e) { x[e] = __builtin_amdgcn_exp2f(x[e] - mnew); ps += x[e]; }
        lrun = lrun * alpha + ps;
#pragma unroll
        for (int dt = 0; dt < 4; ++dt)
#pragma unroll
            for (int e = 0; e < 16; ++e) o[dt][e] *= alpha;
        bf16x8 pf[2];
#pragma unroll
        for (int s2 = 0; s2 < 2; ++s2) { u32x4 w; w.x = cvt_pk_bf16(x[8 * s2 + 0], x[8 * s2 + 1]); w.y = cvt_pk_bf16(x[8 * s2 + 2], x[8 * s2 + 3]); w.z = cvt_pk_bf16(x[8 * s2 + 4], x[8 * s2 + 5]); w.w = cvt_pk_bf16(x[8 * s2 + 6], x[8 * s2 + 7]);
            pf[s2] = __builtin_bit_cast(bf16x8, w); }
#pragma unroll
        for (int dt = 0; dt < 4; ++dt)
#pragma unroll
            for (int s2 = 0; s2 < 2; ++s2) o[dt] = __builtin_amdgcn_mfma_f32_32x32x16_bf16(vf[dt][s2], pf[s2], o[dt], 0, 0, 0);
    }
#undef ATT_DMA
    const float ltot = lrun + __shfl_xor(lrun, 32); const float inv = 1.0f / ltot;
    const size_t orow0 = ((size_t)(g * 64 + b * 4 + (hd & 3)) * SEQ + up0);
    {   LAS unsigned char* ob = lds + 32768 + wave * (32 * 272);
#pragma unroll
        for (int dt = 0; dt < 4; ++dt)
#pragma unroll
            for (int c = 0; c < 4; ++c) { u32x2 w; w.x = cvt_pk_bf16(o[dt][4 * c] * inv, o[dt][4 * c + 1] * inv); w.y = cvt_pk_bf16(o[dt][4 * c + 2] * inv, o[dt][4 * c + 3] * inv);
                *(LAS u32x2*)(ob + ql * 272 + (dt * 32 + 8 * c + 4 * h) * 2) = w; }
        asm volatile("s_waitcnt lgkmcnt(0)" ::: "memory");
        pd.pog = OG + orow0 * 128; pd.plse = LSE + orow0; pd.lsev = mrun + __log2f(ltot);
    }
    asm volatile("s_waitcnt lgkmcnt(0)" ::: "memory");
    __syncthreads();
}

template <int R> __device__ __forceinline__ void combine_rows(const Params& p, int row0, int rstride, int lane) {
    const bf16_t* OG = (const bf16_t*)((unsigned char*)p.out + DO_OG); const float* LSE = (const float*)((unsigned char*)p.out + DO_LSE);
    bf16_t* YB = (bf16_t*)(p.ws + WS_YB);
    const int hg = lane >> 4;
    float l[R][3]; u32x4 v[R][3];
#pragma unroll
    for (int i = 0; i < R; ++i) { const int row = (row0 + i * rstride < M) ? row0 + i * rstride : M - 1; const int bb = row >> 11, sq = row & (SEQ - 1);
#pragma unroll
        for (int g = 0; g < 3; ++g) { const int uu = ((sq & ((1 << (2 * g)) - 1)) << (11 - 2 * g)) + (sq >> (2 * g)); const size_t orow = (size_t)(g * 64 + bb * 4 + hg) * SEQ + uu;
            l[i][g] = LSE[orow]; v[i][g] = *(const u32x4*)(OG + orow * 128 + 8 * (lane & 15)); } }
#pragma unroll
    for (int i = 0; i < R; ++i) { const int row = (row0 + i * rstride < M) ? row0 + i * rstride : M - 1;
        const float mx = fmaxf(l[i][0], fmaxf(l[i][1], l[i][2]));
        float w0 = __builtin_amdgcn_exp2f(l[i][0] - mx), w1 = __builtin_amdgcn_exp2f(l[i][1] - mx), w2 = __builtin_amdgcn_exp2f(l[i][2] - mx);
        const float inv = 1.0f / (w0 + w1 + w2); w0 *= inv; w1 *= inv; w2 *= inv;
        const u32x4 a = v[i][0], bq = v[i][1], c = v[i][2]; u32x4 o;
        o.x = cvt_pk_bf16(w0 * bf_lo(a.x) + w1 * bf_lo(bq.x) + w2 * bf_lo(c.x), w0 * bf_hi(a.x) + w1 * bf_hi(bq.x) + w2 * bf_hi(c.x));
        o.y = cvt_pk_bf16(w0 * bf_lo(a.y) + w1 * bf_lo(bq.y) + w2 * bf_lo(c.y), w0 * bf_hi(a.y) + w1 * bf_hi(bq.y) + w2 * bf_hi(c.y));
        o.z = cvt_pk_bf16(w0 * bf_lo(a.z) + w1 * bf_lo(bq.z) + w2 * bf_lo(c.z), w0 * bf_hi(a.z) + w1 * bf_hi(bq.z) + w2 * bf_hi(c.z));
        o.w = cvt_pk_bf16(w0 * bf_lo(a.w) + w1 * bf_lo(bq.w) + w2 * bf_lo(c.w), w0 * bf_hi(a.w) + w1 * bf_hi(bq.w) + w2 * bf_hi(c.w));
        *(u32x4*)(YB + (size_t)row * 1024 + 8 * lane) = o; }
}

template <int R> __device__ __forceinline__ void h1_rows(const Params& p, int row0, int rstride, int lane) {
    const float* x = p.in[0]; const float* g1 = p.in[11];
    const bf16_t* MIX = (const bf16_t*)(p.ws + WS_MIX); const float* ss1 = (const float*)(p.ws + WS_SS1);
    bf16_t* H1B = (bf16_t*)(p.ws + WS_H1B); float* e2 = (float*)(p.ws + WS_E2);
    f32x4 xv[R][4]; u32x2 mw[R][4]; float r1[R];
#pragma unroll
    for (int i = 0; i < R; ++i) { const int row = (row0 + i * rstride < M) ? row0 + i * rstride : M - 1; r1[i] = ss1[row];
        const f32x4* xr = (const f32x4*)(x + (size_t)row * D) + lane; const u32x2* mr = (const u32x2*)(MIX + (size_t)row * D) + lane;
#pragma unroll
        for (int j = 0; j < 4; ++j) { xv[i][j] = __builtin_nontemporal_load(xr + 64 * j); mw[i][j] = mr[64 * j]; } }
    f32x4 gv[4];
#pragma unroll
    for (int j = 0; j < 4; ++j) gv[j] = ((const f32x4*)g1 + lane)[64 * j];
#pragma unroll
    for (int i = 0; i < R; ++i) { const int row = (row0 + i * rstride < M) ? row0 + i * rstride : M - 1; const float rr = 1.0f / sqrtf(r1[i] * (1.0f / D) + EPS);
        u32x2* o8 = (u32x2*)(H1B + (size_t)row * D) + lane; float s = 0.f;
#pragma unroll
        for (int j = 0; j < 4; ++j) {
            const float h0 = xv[i][j][0] + bf_lo(mw[i][j].x) * rr * gv[j][0], h1 = xv[i][j][1] + bf_hi(mw[i][j].x) * rr * gv[j][1], h2 = xv[i][j][2] + bf_lo(mw[i][j].y) * rr * gv[j][2], h3 = xv[i][j][3] + bf_hi(mw[i][j].y) * rr * gv[j][3];
            s += (h0 * h0 + h1 * h1) + (h2 * h2 + h3 * h3);
            u32x2 w; w.x = cvt_pk_bf16(h0, h1); w.y = cvt_pk_bf16(h2, h3); o8[64 * j] = w; }
        s = wave_sum(s);
        if (lane == 0) { const float t = s * (1.0f / D) + EPS; e2[row] = EPS * t * t; } }
}
template <int R> __device__ __forceinline__ void final_rows(const Params& p, int row0, int rstride, int lane) {
    const float* g3 = p.in[15];
    const bf16_t* H1B = (const bf16_t*)(p.ws + WS_H1B); const bf16_t* MLP = (const bf16_t*)(p.ws + WS_MLP);
    const float* ss2 = (const float*)(p.ws + WS_SS2); const float* e2 = (const float*)(p.ws + WS_E2);
    u32x2 hw[R][4], lw[R][4]; float a2[R], a3[R];
#pragma unroll
    for (int i = 0; i < R; ++i) { const int row = (row0 + i * rstride < M) ? row0 + i * rstride : M - 1; a2[i] = ss2[row]; a3[i] = e2[row];
        const u32x2* hr = (const u32x2*)(H1B + (size_t)row * D) + lane; const u32x2* lr = (const u32x2*)(MLP + (size_t)row * D) + lane;
#pragma unroll
        for (int j = 0; j < 4; ++j) { hw[i][j] = hr[64 * j]; lw[i][j] = lr[64 * j]; } }
    f32x4 gc[4];
#pragma unroll
    for (int j = 0; j < 4; ++j) gc[j] = ((const f32x4*)g3 + lane)[64 * j];
#pragma unroll
    for (int i = 0; i < R; ++i) { const int row = (row0 + i * rstride < M) ? row0 + i * rstride : M - 1;
        const float r3 = 1.0f / sqrtf(a2[i] * (1.0f / D) + a3[i]);
        f32x4* orow = (f32x4*)(p.out + (size_t)row * D) + lane;
#pragma unroll
        for (int j = 0; j < 4; ++j) { f32x4 ov;
            ov[0] = bf_lo(hw[i][j].x) + bf_lo(lw[i][j].x) * r3 * gc[j][0];
            ov[1] = bf_hi(hw[i][j].x) + bf_hi(lw[i][j].x) * r3 * gc[j][1];
            ov[2] = bf_lo(hw[i][j].y) + bf_lo(lw[i][j].y) * r3 * gc[j][2];
            ov[3] = bf_hi(hw[i][j].y) + bf_hi(lw[i][j].y) * r3 * gc[j][3];
            __builtin_nontemporal_store(ov, orow + 64 * j); } }
}

#define XB_TMO      128
#define XB_XCNT(j)  (256  + 64 * (j))
#define XB_XSUB(j)  (1280 + 64 * (j))
#define XB_XGEN(j)  (2304 + 64 * (j))
#define XB_TOP      3328
#define XB_TOPGEN   3392
#define XCD_BAR_WORDS 3456
#define XB_SPIN_CAP (1u << 18)

__device__ __forceinline__ unsigned xb_ld(unsigned* p)              { return __hip_atomic_load(p, __ATOMIC_RELAXED, __HIP_MEMORY_SCOPE_AGENT); }
__device__ __forceinline__ unsigned xb_add(unsigned* p, unsigned v) { return __hip_atomic_fetch_add(p, v, __ATOMIC_RELAXED, __HIP_MEMORY_SCOPE_AGENT); }
__device__ __forceinline__ unsigned xb_xcc_id() { return (unsigned)__builtin_amdgcn_s_getreg((3 << 11) | 20) & 0xFu; }
#define XB_SPIN(cond, bar) do { unsigned _sp = 0; while (cond) { __builtin_amdgcn_s_sleep(1); \
    if ((++_sp & 255u) == 0u) { if (xb_ld(&(bar)[XB_TMO])) break; if (_sp > XB_SPIN_CAP) { atomicAdd(&(bar)[XB_TMO], 1u); break; } } } } while (0)

struct XcdBarrier {
    unsigned* bar; unsigned x;
    volatile LAS unsigned* st;
};

__device__ __forceinline__ XcdBarrier xcd_barrier_post(unsigned* bar, volatile LAS unsigned* st) {
    XcdBarrier b; b.bar = bar; b.x = xb_xcc_id(); b.st = st;
    if (threadIdx.x == 0) (void)xb_add(&bar[XB_XCNT(b.x)], 1u);
    return b;
}
__device__ __forceinline__ void xcd_barrier_complete(unsigned* bar, unsigned x, unsigned& nloc, unsigned& nx) {
    const unsigned G = gridDim.x * gridDim.y * gridDim.z;
    unsigned sum, cnt, mine, sp = 0u;
    for (;;) {
        sum = 0u; cnt = 0u; mine = 0u;
#pragma unroll
        for (unsigned j = 0; j < 16; ++j) { const unsigned c = xb_ld(&bar[XB_XCNT(j)]); sum += c; cnt += (c > 0u) ? 1u : 0u; mine = (j == x) ? c : mine; }
        if (sum == G) break;
        __builtin_amdgcn_s_sleep(1);
        if ((++sp & 255u) == 0u) { if (xb_ld(&bar[XB_TMO])) break; if (sp > XB_SPIN_CAP) { atomicAdd(&bar[XB_TMO], 1u); break; } }
    }
    nloc = mine > 0u ? mine : 1u; nx = cnt > 0u ? cnt : 1u;
}

__device__ __forceinline__ void xcd_barrier(const XcdBarrier& b) {
    asm volatile("s_waitcnt vmcnt(0)" ::: "memory");
    __syncthreads();
    if (threadIdx.x == 0) {
        unsigned* bar = b.bar;
        __builtin_amdgcn_s_waitcnt(0);
        unsigned nloc = b.st[0], nx = b.st[1];
        if (nloc == 0u) { xcd_barrier_complete(bar, b.x, nloc, nx); b.st[0] = nloc; b.st[1] = nx; }
        const unsigned old = xb_add(&bar[XB_XSUB(b.x)], 1u);
        const unsigned gen = old / nloc;
        if (old + 1u == (gen + 1u) * nloc) {
            __builtin_amdgcn_fence(__ATOMIC_RELEASE, "agent");
            asm volatile("s_waitcnt vmcnt(0)" ::: "memory");
            const unsigned og = xb_add(&bar[XB_TOP], 1u);
            const unsigned tg = og / nx;
            if (og + 1u == (tg + 1u) * nx) xb_add(&bar[XB_TOPGEN], 1u);
            else XB_SPIN(xb_ld(&bar[XB_TOPGEN]) == tg, bar);
            __builtin_amdgcn_fence(__ATOMIC_ACQUIRE, "agent");
            xb_add(&bar[XB_XGEN(b.x)], 1u);
            asm volatile("s_waitcnt vmcnt(0)" ::: "memory");
        } else {
            XB_SPIN(xb_ld(&bar[XB_XGEN(b.x)]) == gen, bar);
            __builtin_amdgcn_fence(__ATOMIC_ACQUIRE, "agent");
            asm volatile("s_waitcnt vmcnt(0)" ::: "memory");
        }
    }
    __syncthreads();
}


#ifndef MK_MULTI
#define MK_MULTI 0
#endif

#ifndef PH_MASK
#define PH_MASK 0x3ff
#endif
__device__ __forceinline__ int tid_fresh() { int t = threadIdx.x; asm volatile("" : "+v"(t)); return t; }
template <int ph> __device__ __forceinline__ void run_phase(LAS unsigned char* lds, int G, int bid) {
    if constexpr (ph < 10 && !((PH_MASK >> ph) & 1)) return;
    const Params p = load_params();
    const int tid = tid_fresh(), lane = tid & 63, wave = __builtin_amdgcn_readfirstlane(tid >> 6);
    unsigned char* ws = p.ws; unsigned char* dob = (unsigned char*)p.out;
    if constexpr (ph == 0) { phase_prep(p, lds, G, bid); }
    else if constexpr (ph == 1) {
        { pg8::Gemm g{(const bf16_t*)(dob + DO_XB), (const bf16_t*)(dob + DO_WIN), 1024, 1024, 1024, 0, 1}; pg8::InOrder S; S.init(M, G, bid);
          pg8::EpiIn E{(const float*)(ws + WS_RSTD0), (bf16_t*)(ws + WS_Z), (bf16_t*)(ws + WS_Q), (bf16_t*)(ws + WS_K), (bf16_t*)(ws + WS_G), p.in[3], (const float2*)(ws + WS_ROPE)};
          pg8::gemm_phase<pg8::EpiIn, pg8::InOrder, true, true>(lds, g, S, E); }
#pragma unroll 1
        for (int hg = 0; hg < 3; ++hg) {
            pg8::Gemm g{(const bf16_t*)(dob + DO_WIN) + (size_t)4096 * 1024, (const bf16_t*)(dob + DO_XB), 1024, 1024, 1024, hg == 2 ? 2 : 1, 1 << (2 * hg)}; pg8::VtOrder S; S.init(hg, G, bid);
            pg8::EpiVT E{(const float*)(ws + WS_RSTDU), (bf16_t*)(ws + WS_VT), hg};
            pg8::gemm_phase<pg8::EpiVT, pg8::VtOrder, true, true>(lds, g, S, E);
        }
    } else if constexpr (ph == 2 || ph == 12) {
        { AttnPend pd; pd.pog = nullptr; pd.plse = nullptr; pd.lsev = 0.f;
          for (int u = bid; u < NB * 12 * 8; u += G) attn_block_unit(p, lds, u, pd, wave, lane);
          if (pd.pog != nullptr) { attn_flush(pd, lds + 32768 + wave * (32 * 272), lane, 0, 8); if ((lane >> 5) == 0) pd.plse[lane & 31] = pd.lsev; }
          asm volatile("s_waitcnt lgkmcnt(0)" ::: "memory"); __syncthreads(); }
    } else if constexpr (ph == 3) {
        const bool gmlp_first = ((bid >> 3) & 1) == 0;
        if (gmlp_first) for (int c = bid; c < M / 128; c += G) gmlp_unit(p, lds, c);
        for (int m = bid * 8 + wave; m < M; m += G * 8 * 2) combine_rows<2>(p, m, G * 8, lane);
        if (!gmlp_first) for (int c = bid; c < M / 128; c += G) gmlp_unit(p, lds, c);
    } else if constexpr (ph == 4) {
        pg8::Gemm g{(const bf16_t*)(ws + WS_Z), (const bf16_t*)(ws + WS_WAB), 1024, 512, 512, 0, 1}; pg8::TwoPartOrder S; S.init(M, 1024, G, bid);
        pg8::EpiMerge E{(const bf16_t*)(ws + WS_G), (bf16_t*)(ws + WS_MERGED)};
        pg8::gemm_phase<pg8::EpiMerge, pg8::TwoPartOrder, true, true>(lds, g, S, E);
    } else if constexpr (ph == 5) {
        pg8::Gemm g{(const bf16_t*)(ws + WS_MERGED), (const bf16_t*)(ws + WS_WOUT), 1024, 1024, 1024, 0, 1}; pg8::StaticOrder S; S.init(M, 1024, G, bid);
        pg8::EpiStore<0, true> E{(bf16_t*)(ws + WS_MIX), 1024, (float*)(ws + WS_SS1)};
        pg8::gemm_phase<pg8::EpiStore<0, true>, pg8::StaticOrder, true, true>(lds, g, S, E);
    } else if constexpr (ph == 6) {
        for (int m = bid * 8 + wave; m < M; m += G * 8 * 2) h1_rows<2>(p, m, G * 8, lane);
    } else if constexpr (ph == 7) {
        pg8::Gemm g{(const bf16_t*)(ws + WS_H1B), (const bf16_t*)(ws + WS_WUP), 1024, 1024, 1024, 0, 1}; pg8::StaticOrder S; S.init(M, FF, G, bid);
        pg8::EpiStore<1, false> E{(bf16_t*)(ws + WS_HID), FF, nullptr};
        pg8::gemm_phase<pg8::EpiStore<1, false>, pg8::StaticOrder, true, true>(lds, g, S, E);
    } else if constexpr (ph == 8) {
        pg8::Gemm g{(const bf16_t*)(ws + WS_HID), (const bf16_t*)(ws + WS_WDOWN), FF, FF, FF, 0, 1}; pg8::StaticOrder S; S.init(M, 1024, G, bid);
        pg8::EpiStore<0, true> E{(bf16_t*)(ws + WS_MLP), 1024, (float*)(ws + WS_SS2)};
        pg8::gemm_phase<pg8::EpiStore<0, true>, pg8::StaticOrder, true, true>(lds, g, S, E);
    } else {
        for (int m = bid * 8 + wave; m < M; m += G * 8 * 2) final_rows<2>(p, m, G * 8, lane);
    }
}
constexpr int NPHASE = 10;

#if MK_MULTI
template <int PH> __global__ void __launch_bounds__(512, 2) fwd_phase(Params p) {
    extern __shared__ __attribute__((aligned(16))) unsigned char lds_raw[];
    run_phase<PH>((LAS unsigned char*)lds_raw, (int)gridDim.x, (int)blockIdx.x);
}
#else
__global__ void __launch_bounds__(512, 2) fwd_mega(Params p) {
    extern __shared__ __attribute__((aligned(16))) unsigned char lds_raw[];
    LAS unsigned char* lds = (LAS unsigned char*)lds_raw;
    cg::grid_group grid = cg::this_grid();
    const int G = (int)gridDim.x, bid = (int)blockIdx.x;
#define SEAM() do { __syncthreads(); grid.sync(); } while (0)
    volatile LAS unsigned* bst = (volatile LAS unsigned*)(lds + LDS_BYTES - 16);
    if (threadIdx.x == 0) { bst[0] = 0u; bst[1] = 0u; }
    __syncthreads();
    XcdBarrier xbar; xbar.bar = (unsigned*)(load_params().ws + WS_BAR); xbar.x = 0; xbar.st = bst;
    if (bid == 0) for (int i = threadIdx.x; i < 4096; i += 512) __hip_atomic_store(xbar.bar + i, 0u, __ATOMIC_RELAXED, __HIP_MEMORY_SCOPE_AGENT);
    __syncthreads(); grid.sync();
    xbar = xcd_barrier_post(xbar.bar, bst);
#define SEAMK(k) xcd_barrier(xbar)
#ifndef REP_MASK
#define REP_MASK 0
#endif
#define REP(k) do { if constexpr ((REP_MASK >> (k)) & 1) { run_phase<((k) == 2 ? 12 : (k))>(lds, G, bid); SEAM(); } } while (0)
    run_phase<0>(lds, G, bid); SEAMK(0); REP(0);
    run_phase<1>(lds, G, bid); SEAMK(1); REP(1);
    run_phase<2>(lds, G, bid); SEAMK(2); REP(2);
    run_phase<3>(lds, G, bid); SEAMK(3); REP(3);
    run_phase<4>(lds, G, bid); SEAMK(4); REP(4);
    run_phase<5>(lds, G, bid); SEAMK(5);
    run_phase<6>(lds, G, bid); SEAMK(6); REP(6);
    run_phase<7>(lds, G, bid); SEAMK(7); REP(7);
    run_phase<8>(lds, G, bid); SEAMK(8);
    run_phase<9>(lds, G, bid);
#undef SEAM
}
#endif

extern "C" void kernel_launch(void* const* d_in, const int* in_sizes, int n_in, void* d_out, int out_size, void* d_ws, size_t ws_size, hipStream_t stream) {
    static int grid = 0;
    if (grid == 0) {
        if (n_in != 16 || in_sizes[0] != M * D || out_size != M * D || ws_size < WS_NEED) { fprintf(stderr, "kernel_launch: unexpected shapes: n_in %d in0 %d out %d ws %zu (need %zu)\n", n_in, n_in > 0 ? in_sizes[0] : -1, out_size, ws_size, (size_t)WS_NEED); grid = -1; return; }
        int dev = 0, cus = 0, per_cu = 0;
        (void)hipGetDevice(&dev); (void)hipDeviceGetAttribute(&cus, hipDeviceAttributeMultiprocessorCount, dev);
#if MK_MULTI
        const void* fn = (const void*)fwd_phase<1>;
#else
        const void* fn = (const void*)fwd_mega;
#endif
        if (hipFuncSetAttribute(fn, hipFuncAttributeMaxDynamicSharedMemorySize, LDS_BYTES) != hipSuccess) { fprintf(stderr, "kernel_launch: hipFuncSetAttribute failed\n"); grid = -1; return; }
        if (hipOccupancyMaxActiveBlocksPerMultiprocessor(&per_cu, fn, 512, LDS_BYTES) != hipSuccess || per_cu < 1) { fprintf(stderr, "kernel_launch: occupancy query gave %d\n", per_cu); per_cu = 1; }
        (void)hipGetLastError();
        grid = cus * per_cu;
    }
    if (grid < 0) return;
    Params p{};
    for (int i = 0; i < 16; ++i) p.in[i] = (const float*)d_in[i];
    p.out = (float*)d_out; p.ws = (unsigned char*)d_ws;
#if MK_MULTI
#define LP(k) do { (void)hipFuncSetAttribute((const void*)fwd_phase<k>, hipFuncAttributeMaxDynamicSharedMemorySize, LDS_BYTES); hipLaunchKernelGGL(fwd_phase<k>, dim3(grid), dim3(512), LDS_BYTES, stream, p); } while (0)
    LP(0); LP(1); LP(2); LP(3); LP(4); LP(5); LP(6); LP(7); LP(8); LP(9);
#undef LP
#else
    void* args[] = {&p};
    hipError_t e = hipLaunchCooperativeKernel((const void*)fwd_mega, dim3(grid), dim3(512), args, LDS_BYTES, stream);
    if (e != hipSuccess) fprintf(stderr, "kernel_launch: cooperative launch failed: %s (grid %d)\n", hipGetErrorString(e), grid);
#endif
}
```
